# Optimizing an MI355X kernel written in HIP

```python
import math
import jax, jax.numpy as jnp
from jax import lax
import numpy as np

D_MODEL = 2048
BATCH = 4
SEQ = 2048
DEPTH = 1

CTX_LEN = 256
GRID_W = 64
EPS = 1e-6
N_MOD = 6

SSD_HEADS = 32
SSD_HEAD_DIM = 64
D_SSD = SSD_HEADS * SSD_HEAD_DIM
SSD_GROUPS = 4
HEADS_PER_GROUP = SSD_HEADS // SSD_GROUPS
D_STATE = 128
SSD_CONV = 3
CHUNK = 128
D_BC = SSD_GROUPS * D_STATE
D_XBC = D_SSD + 2 * D_BC

D_CONF = 2048
CONF_KERNEL = 31

D_MIX = D_SSD + D_CONF
OFF_XBC = D_SSD
OFF_DT = OFF_XBC + D_XBC
OFF_CONF = OFF_DT + 2 * SSD_HEADS
N_IN = OFF_CONF + 2 * D_CONF

N_EXPERTS = 32
TOP_K = 4
D_FF = D_MODEL
SWIGLU_LIMIT = 7.0
SWIGLU_ALPHA = 1.702
MOE_BLOCK = 128

kernel_name = "hybrid_ssd_conformer_moe_diffusion_block"


def rmsnorm(x, g):
    xf = x.astype(jnp.float32)
    y = xf * lax.rsqrt(jnp.mean(xf * xf, axis=-1, keepdims=True) + EPS)
    return (y * g.astype(jnp.float32)).astype(x.dtype)


def modulate(h, shift, scale):
    return h * (1 + scale) + shift


def dwconv1d(x, w, b):
    k, ch = w.shape
    y = lax.conv_general_dilated(x, w[:, None, :].astype(x.dtype), window_strides=(1,),
                                 padding=[(k // 2, k // 2)], dimension_numbers=("NWC", "WIO", "NWC"),
                                 feature_group_count=ch)
    return y + b.astype(x.dtype)


def segsum(a):
    t = a.shape[-1]
    ae = jnp.broadcast_to(a[..., :, None], a.shape + (t,))
    ae = jnp.where(jnp.tril(jnp.ones((t, t), bool), -1), ae, 0.0)
    s = jnp.cumsum(ae, axis=-2)
    return jnp.where(jnp.tril(jnp.ones((t, t), bool)), s, -jnp.inf)


def ssd_chunked(x, a, bm, cm, init, want_y):
    bsz, t, _, p = x.shape
    nc = t // CHUNK
    x = x.reshape(bsz, nc, CHUNK, SSD_GROUPS, HEADS_PER_GROUP, p)
    a = a.reshape(bsz, nc, CHUNK, SSD_GROUPS, HEADS_PER_GROUP).transpose(0, 3, 4, 1, 2)
    bm = bm.reshape(bsz, nc, CHUNK, SSD_GROUPS, D_STATE)
    cm = cm.reshape(bsz, nc, CHUNK, SSD_GROUPS, D_STATE)
    a_cum = jnp.cumsum(a, axis=-1)
    decay_states = jnp.exp(a_cum[..., -1:] - a_cum)
    states = jnp.einsum("bclgn,bgrcl,bclgrp->bcgrpn", bm, decay_states, x)
    init = init.reshape(bsz, 1, SSD_GROUPS, HEADS_PER_GROUP, p, D_STATE)
    states = jnp.concatenate([init, states], axis=1)
    a_last = jnp.pad(a_cum[..., -1], ((0, 0), (0, 0), (0, 0), (1, 0)))
    chunk_decay = jnp.exp(segsum(a_last))
    new_states = jnp.einsum("bgrzc,bcgrpn->bzgrpn", chunk_decay, states)
    final = new_states[:, -1].reshape(bsz, SSD_HEADS, p, D_STATE)
    if not want_y:
        return None, final
    prev_states = new_states[:, :-1]
    lmat = jnp.exp(segsum(a))
    cb = jnp.einsum("bclgn,bcsgn->bgcls", cm, bm)
    y_diag = jnp.einsum("bgcls,bgrcls,bcsgrp->bclgrp", cb, lmat, x)
    y_off = jnp.einsum("bclgn,bcgrpn,bgrcl->bclgrp", cm, prev_states, jnp.exp(a_cum))
    return (y_diag + y_off).reshape(bsz, t, SSD_HEADS, p), final


def ssd_prepare(xbc_dt, conv_w, conv_b):
    bsz, t, _ = xbc_dt.shape
    xbc = jax.nn.silu(dwconv1d(xbc_dt[..., :D_XBC], conv_w, conv_b))
    xs = xbc[..., :D_SSD].reshape(bsz, t, SSD_HEADS, SSD_HEAD_DIM)
    bm = xbc[..., D_SSD:D_SSD + D_BC].reshape(bsz, t, SSD_GROUPS, D_STATE)
    cm = xbc[..., D_SSD + D_BC:].reshape(bsz, t, SSD_GROUPS, D_STATE)
    dt_f = xbc_dt[..., D_XBC:D_XBC + SSD_HEADS]
    dt_b = xbc_dt[..., D_XBC + SSD_HEADS:]
    return xs, bm, cm, dt_f, dt_b


def ssd_scan(xs, bm, cm, dt_raw, a_log, dt_bias, init, want_y):
    f32 = jnp.float32
    dt = jax.nn.softplus(dt_raw.astype(f32) + dt_bias.astype(f32))
    a = dt * (-jnp.exp(a_log.astype(f32)))
    return ssd_chunked(xs.astype(f32) * dt[..., None], a, bm.astype(f32), cm.astype(f32), init, want_y)


def ssd_bidir(xs, bm, cm, dt_f, dt_b, par_f, par_b, init_f, init_b, want_y):
    y_f, fin_f = ssd_scan(xs, bm, cm, dt_f, par_f[0], par_f[1], init_f, want_y)
    y_b, fin_b = ssd_scan(xs[:, ::-1], bm[:, ::-1], cm[:, ::-1], dt_b[:, ::-1], par_b[0], par_b[1], init_b, want_y)
    y = y_f + y_b[:, ::-1] if want_y else None
    return y, fin_f, fin_b


def ssd_output(y, xs, z, d_skip, norm_g):
    f32 = jnp.float32
    bsz, t = z.shape[:2]
    y = y + d_skip.astype(f32)[:, None] * xs.astype(f32)
    y = y.reshape(bsz, t, D_SSD) * jax.nn.silu(z.astype(f32))
    y = y.reshape(bsz, t, SSD_GROUPS, D_SSD // SSD_GROUPS)
    y = y * lax.rsqrt(jnp.mean(y * y, axis=-1, keepdims=True) + EPS)
    return (y.reshape(bsz, t, D_SSD) * norm_g.astype(f32)).astype(z.dtype)


def conformer_conv(u, dw_w, dw_b, ln_g, ln_b, rows):
    a, g = jnp.split(u, 2, axis=-1)
    v = a * jax.nn.sigmoid(g)
    bsz, t, ch = v.shape
    if rows is None:
        v = dwconv1d(v, dw_w, dw_b)
    else:
        half = ch // 2
        vg = v.reshape(bsz, rows, GRID_W, ch)
        v_row = dwconv1d(vg[..., :half].reshape(bsz * rows, GRID_W, half), dw_w[:, :half], dw_b[:half])
        v_row = v_row.reshape(bsz, rows, GRID_W, half)
        v_col = vg[..., half:].transpose(0, 2, 1, 3).reshape(bsz * GRID_W, rows, ch - half)
        v_col = dwconv1d(v_col, dw_w[:, half:], dw_b[half:])
        v_col = v_col.reshape(bsz, GRID_W, rows, ch - half).transpose(0, 2, 1, 3)
        v = jnp.concatenate([v_row, v_col], axis=-1).reshape(bsz, t, ch)
    vf = v.astype(jnp.float32)
    mu = jnp.mean(vf, axis=-1, keepdims=True)
    var = jnp.mean(jnp.square(vf - mu), axis=-1, keepdims=True)
    vf = (vf - mu) * lax.rsqrt(var + EPS) * ln_g.astype(jnp.float32) + ln_b.astype(jnp.float32)
    return jax.nn.silu(vf).astype(u.dtype)


def moe_ffn(h, w_router, b_router, w_gu, b_gu, w_down, b_down):
    n_tok = h.shape[0]
    logits = (h @ w_router + b_router).astype(jnp.float32)
    top_logit, top_idx = lax.top_k(logits, TOP_K)
    top_w = jax.nn.softmax(top_logit, axis=-1).astype(h.dtype)
    n_slot = n_tok * TOP_K
    e_flat = top_idx.reshape(-1)
    order = jnp.argsort(e_flat)
    e_sorted = e_flat[order]
    tok_sorted = (jnp.arange(n_slot, dtype=jnp.int32) // TOP_K)[order]
    w_sorted = top_w.reshape(-1)[order]
    counts = jnp.bincount(e_flat, length=N_EXPERTS)
    starts = jnp.cumsum(counts) - counts
    padded = (counts + MOE_BLOCK - 1) // MOE_BLOCK * MOE_BLOCK
    pad_ends = jnp.cumsum(padded)
    dest = (pad_ends - padded)[e_sorted] + jnp.arange(n_slot, dtype=jnp.int32) - starts[e_sorted]
    n_blocks = -(-n_slot // MOE_BLOCK) + N_EXPERTS
    n_pad = n_blocks * MOE_BLOCK
    slot_tok = jnp.zeros((n_pad,), jnp.int32).at[dest].set(tok_sorted)
    slot_w = jnp.zeros((n_pad,), h.dtype).at[dest].set(w_sorted)
    block_e = jnp.searchsorted(pad_ends, jnp.arange(n_blocks, dtype=jnp.int32) * MOE_BLOCK, side="right")
    block_e = jnp.minimum(block_e, N_EXPERTS - 1)

    def expert_block(args):
        e, tok, wt = args
        xb = h[tok]
        gu = xb @ w_gu[e] + b_gu[e]
        glu = jnp.minimum(gu[:, :D_FF], SWIGLU_LIMIT)
        lin = jnp.clip(gu[:, D_FF:], -SWIGLU_LIMIT, SWIGLU_LIMIT)
        act = glu * jax.nn.sigmoid(SWIGLU_ALPHA * glu) * (lin + 1)
        return (act @ w_down[e] + b_down[e]) * wt[:, None]

    out = lax.map(expert_block, (block_e, slot_tok.reshape(n_blocks, MOE_BLOCK), slot_w.reshape(n_blocks, MOE_BLOCK)))
    return jax.ops.segment_sum(out.reshape(n_pad, -1), slot_tok, num_segments=n_tok)


def setup_inputs(seed: int = 0) -> dict:
    key = jax.random.key(seed)
    ks = jax.random.split(key, 32)
    f32 = jnp.float32
    L = DEPTH

    def nrm(k, shape, s):
        return jax.random.normal(k, shape, f32) * s

    def gain(k, shape):
        return 1.0 + 0.01 * jax.random.normal(k, shape, f32)

    def dt_bias_init(k):
        dt0 = jnp.exp(jax.random.uniform(k, (L, SSD_HEADS), f32, math.log(1e-3), math.log(1e-1)))
        return dt0 + jnp.log(-jnp.expm1(-dt0))

    def a_log_init(k):
        return jnp.log(jax.random.uniform(k, (L, SSD_HEADS), f32, 1.0, 16.0))

    return {
        "x": nrm(ks[0], (BATCH, SEQ, D_MODEL), 1.0),
        "c": nrm(ks[1], (BATCH, D_MODEL), 1.0),
        "ctx": nrm(ks[2], (BATCH, CTX_LEN, D_MODEL), 1.0),
        "c_ctx": nrm(ks[3], (D_MODEL,), 1.0),
        "w_mod": nrm(ks[4], (L, D_MODEL, N_MOD * D_MODEL), 0.5 * D_MODEL ** -0.5),
        "b_mod": nrm(ks[5], (L, N_MOD * D_MODEL), 0.02),
        "norm_mix_g": gain(ks[6], (L, D_MODEL)),
        "norm_ffn_g": gain(ks[7], (L, D_MODEL)),
        "w_in": nrm(ks[8], (L, D_MODEL, N_IN), D_MODEL ** -0.5),
        "ssd_conv_w": nrm(ks[9], (L, SSD_CONV, D_XBC), SSD_CONV ** -0.5),
        "ssd_conv_b": nrm(ks[10], (L, D_XBC), 0.02),
        "ssd_a_log_f": a_log_init(ks[11]),
        "ssd_dt_bias_f": dt_bias_init(ks[12]),
        "ssd_a_log_b": a_log_init(ks[13]),
        "ssd_dt_bias_b": dt_bias_init(ks[14]),
        "ssd_d_skip": gain(ks[15], (L, SSD_HEADS)),
        "ssd_norm_g": gain(ks[16], (L, D_SSD)),
        "conf_dw_w": nrm(ks[17], (L, CONF_KERNEL, D_CONF), CONF_KERNEL ** -0.5),
        "conf_dw_b": nrm(ks[18], (L, D_CONF), 0.02),
        "conf_ln_g": gain(ks[19], (L, D_CONF)),
        "conf_ln_b": nrm(ks[20], (L, D_CONF), 0.02),
        "w_out": nrm(ks[21], (L, D_MIX, D_MODEL), D_MIX ** -0.5),
        "w_router": nrm(ks[22], (L, D_MODEL, N_EXPERTS), D_MODEL ** -0.5),
        "b_router": nrm(ks[23], (L, N_EXPERTS), 0.01),
        "w_gate_up": nrm(ks[24], (L, N_EXPERTS, D_MODEL, 2 * D_FF), D_MODEL ** -0.5),
        "b_gate_up": nrm(ks[25], (L, N_EXPERTS, 2 * D_FF), 0.02),
        "w_down": nrm(ks[26], (L, N_EXPERTS, D_FF, D_MODEL), D_FF ** -0.5),
        "b_down": nrm(ks[27], (L, N_EXPERTS, D_MODEL), 0.02),
        "final_norm_g": gain(ks[28], (D_MODEL,)),
    }


def reference(x, c, ctx, c_ctx, w_mod, b_mod, norm_mix_g, norm_ffn_g, w_in, ssd_conv_w, ssd_conv_b,
              ssd_a_log_f, ssd_dt_bias_f, ssd_a_log_b, ssd_dt_bias_b, ssd_d_skip, ssd_norm_g,
              conf_dw_w, conf_dw_b, conf_ln_g, conf_ln_b, w_out, w_router, b_router,
              w_gate_up, b_gate_up, w_down, b_down, final_norm_g):
    bsz, n_lat, _ = x.shape
    rows = n_lat // GRID_W
    xc = ctx
    for l in range(DEPTH):
        last = l == DEPTH - 1
        mod = jax.nn.silu(c) @ w_mod[l] + b_mod[l]
        sh_m, sc_m, g_m, sh_f, sc_f, g_f = jnp.split(mod[:, None, :], N_MOD, axis=-1)
        n_ctx_mod = 2 if last else N_MOD
        mod_c = jax.nn.silu(c_ctx) @ w_mod[l][:, :n_ctx_mod * D_MODEL] + b_mod[l][:n_ctx_mod * D_MODEL]
        mod_c = jnp.split(mod_c, n_ctx_mod)
        par_f = (ssd_a_log_f[l], ssd_dt_bias_f[l])
        par_b = (ssd_a_log_b[l], ssd_dt_bias_b[l])

        h = modulate(rmsnorm(x, norm_mix_g[l]), sh_m, sc_m)
        hc = modulate(rmsnorm(xc, norm_mix_g[l]), mod_c[0], mod_c[1])
        proj = h @ w_in[l]
        proj_c = hc @ (w_in[l][:, OFF_XBC:OFF_CONF] if last else w_in[l])
        ssd_in_c = proj_c if last else proj_c[..., OFF_XBC:OFF_CONF]

        xs_c, bm_c, cm_c, dtf_c, dtb_c = ssd_prepare(ssd_in_c, ssd_conv_w[l], ssd_conv_b[l])
        zero_state = jnp.zeros((bsz, SSD_HEADS, SSD_HEAD_DIM, D_STATE), jnp.float32)
        y_c, fin_f, fin_b = ssd_bidir(xs_c, bm_c, cm_c, dtf_c, dtb_c, par_f, par_b, zero_state, zero_state, not last)

        xs, bm, cm, dtf, dtb = ssd_prepare(proj[..., OFF_XBC:OFF_CONF], ssd_conv_w[l], ssd_conv_b[l])
        y, _, _ = ssd_bidir(xs, bm, cm, dtf, dtb, par_f, par_b, fin_f, fin_b, True)
        ssd_out = ssd_output(y, xs, proj[..., :OFF_XBC], ssd_d_skip[l], ssd_norm_g[l])
        conf_out = conformer_conv(proj[..., OFF_CONF:], conf_dw_w[l], conf_dw_b[l], conf_ln_g[l], conf_ln_b[l], rows)
        x = x + g_m * (jnp.concatenate([ssd_out, conf_out], axis=-1) @ w_out[l])

        h2 = modulate(rmsnorm(x, norm_ffn_g[l]), sh_f, sc_f)
        x = x + g_f * moe_ffn(h2.reshape(-1, D_MODEL), w_router[l], b_router[l], w_gate_up[l], b_gate_up[l],
                              w_down[l], b_down[l]).reshape(x.shape)

        if not last:
            ssd_out_c = ssd_output(y_c, xs_c, proj_c[..., :OFF_XBC], ssd_d_skip[l], ssd_norm_g[l])
            conf_out_c = conformer_conv(proj_c[..., OFF_CONF:], conf_dw_w[l], conf_dw_b[l], conf_ln_g[l], conf_ln_b[l], None)
            xc = xc + mod_c[2] * (jnp.concatenate([ssd_out_c, conf_out_c], axis=-1) @ w_out[l])
            h2c = modulate(rmsnorm(xc, norm_ffn_g[l]), mod_c[3], mod_c[4])
            xc = xc + mod_c[5] * moe_ffn(h2c.reshape(-1, D_MODEL), w_router[l], b_router[l], w_gate_up[l],
                                         b_gate_up[l], w_down[l], b_down[l]).reshape(xc.shape)
    return rmsnorm(x, final_norm_g)
```

```cpp
#include <hip/hip_runtime.h>
#include <cstdio>
#include <cstdint>

namespace pg8 {
#define PG8_LAS __attribute__((address_space(3)))
typedef unsigned short bf16_t;
typedef short bf16x8 __attribute__((ext_vector_type(8)));
typedef float f32x4 __attribute__((ext_vector_type(4)));
typedef unsigned u32x4 __attribute__((ext_vector_type(4)));
typedef int i32x4 __attribute__((ext_vector_type(4)));
constexpr int BM = 256, BK = 64, HALF = 128, HTB = HALF * BK * 2  , STAGE_BYTES = 8 * HTB, NXCD = 8, WGM = 8;

__host__ __device__ __forceinline__ int lds_byte(int r, int c) { const int st = (r >> 4) * 2 + (c >> 5), rr = r & 15, cc = c & 31, ob = rr * 64 + cc * 2; return st * 1024 + (ob ^ (((ob >> 9) & 1) << 5)); }
__host__ __device__ __forceinline__ void stage_rc(int b, int& R, int& C) { const int st = b / 1024, sb = b % 1024, swz = sb ^ (((sb >> 9) & 1) << 5); R = (st >> 1) * 16 + swz / 64; C = (st & 1) * 32 + (swz % 64) / 2; }
__host__ __device__ __forceinline__ int perm32(int rho) { const int n = rho >> 4, i = rho & 15; return 8 * (i >> 2) + 4 * n + (i & 3); }

struct Unit { int pm, pn; };
struct Gemm { const bf16_t* A; const bf16_t* Bt; int M, N, K; };

struct StaticOrder {
    int nM, nN, nwg, G, c;
    __host__ __device__ void init(int M, int N, int G_, int c_) { nM = M / BM; nN = N / BM; nwg = nM * nN; G = G_; c = c_; }
    __host__ __device__ bool next(int i, Unit& u) const {
        const long L = (long)i * G + c; if (L >= nwg) return false;
        int wgid = (int)L; { const int q = nwg / NXCD, r = nwg % NXCD, xcd = wgid % NXCD, off = wgid / NXCD; wgid = (xcd < r ? xcd * (q + 1) : r * (q + 1) + (xcd - r) * q) + off; }
        const int nig = WGM * nN, gid = wgid / nig, fm = gid * WGM, gsz = (nM - fm) < WGM ? (nM - fm) : WGM;
        u.pm = fm + ((wgid % nig) % gsz); u.pn = (wgid % nig) / gsz; return true;
    }
    __device__ __forceinline__ void a_ready(const Unit&) const {}
    __device__ __forceinline__ void done(const Unit&) const {}
};
__device__ __forceinline__ unsigned cvt_pk_bf16(float lo, float hi) { unsigned r; asm volatile("v_cvt_pk_bf16_f32 %0, %1, %2" : "=v"(r) : "v"(lo), "v"(hi)); return r; }
typedef float f32x2 __attribute__((ext_vector_type(2)));
template <class Epi, class Sched, bool ALIGN_EPI = false, bool SP2 = false, bool I8 = false, bool HALFM = false>
__device__ __forceinline__ void gemm_phase(PG8_LAS unsigned char* lds, const Gemm g, const Sched& S, const Epi& E) {
    int tid_ = threadIdx.x; asm volatile("" : "+v"(tid_));
    const int tid = tid_, wid = __builtin_amdgcn_readfirstlane(tid >> 6), lane = tid & 63, wr = wid >> 2, wc = wid & 3, fr = lane & 15, fq = lane >> 4;
    const int K = g.K, nt = K / BK;
    unsigned voffA[2], voffB[2];
#pragma unroll
    for (int i = 0; i < 2; ++i) { int R, C; stage_rc(tid * 16 + i * 8192, R, C); const int Rb = Epi::PERM ? ((R & ~31) + perm32(R & 31)) : R;
        voffA[i] = (unsigned)(R * K + C) * 2u; voffB[i] = (unsigned)(Rb * K + C) * 2u; }
    const size_t kstep = (size_t)(BK * 2);
    const size_t hstep = (size_t)HALF * K * 2;
    const size_t tstep = 2 * hstep;
    const unsigned ldsw = (unsigned)wid * 1024u;
    const int aoff = lds_byte(wr * 64 + fr, fq * 8), boff = lds_byte(wc * 32 + fr, fq * 8);
#define PG8_SA(b, h) (((b) * 2 + (h)) * HTB)
#define PG8_SB(b, h) ((4 + (b) * 2 + (h)) * HTB)
#define PG8_STAGE(bufoff, gbase, voff) do { _Pragma("unroll") for (int _i = 0; _i < 2; ++_i) \
        __builtin_amdgcn_global_load_lds((const unsigned*)((const char*)(gbase) + (voff)[_i]), (PG8_LAS unsigned*)(lds + (bufoff) + ldsw + _i * 8192), 16, 0, 0); } while (0)
#define PG8_LDA(dst, b, h) do { _Pragma("unroll") for (int m = 0; m < 4; ++m) _Pragma("unroll") for (int k = 0; k < 2; ++k) dst[m][k] = *(const PG8_LAS bf16x8*)(lds + PG8_SA(b, h) + aoff + m * 2048 + k * 1024); } while (0)
#define PG8_LDB(dst, b, h) do { _Pragma("unroll") for (int n = 0; n < 2; ++n) _Pragma("unroll") for (int k = 0; k < 2; ++k) dst[n][k] = *(const PG8_LAS bf16x8*)(lds + PG8_SB(b, h) + boff + n * 2048 + k * 1024); } while (0)
#define PG8_MMA(ai, bj, At, Bt) do { __builtin_amdgcn_s_setprio(1); _Pragma("unroll") for (int m = 0; m < 4; ++m) _Pragma("unroll") for (int n = 0; n < 2; ++n) _Pragma("unroll") for (int k = 0; k < 2; ++k) { \
        if constexpr (I8) acc[ai][bj][m][n] = __builtin_bit_cast(f32x4, __builtin_amdgcn_mfma_i32_16x16x64_i8(__builtin_bit_cast(i32x4, Bt[n][k]), __builtin_bit_cast(i32x4, At[m][k]), __builtin_bit_cast(i32x4, acc[ai][bj][m][n]), 0, 0, 0)); \
        else acc[ai][bj][m][n] = __builtin_amdgcn_mfma_f32_16x16x32_bf16(Bt[n][k], At[m][k], acc[ai][bj][m][n], 0, 0, 0); } __builtin_amdgcn_s_setprio(0); } while (0)
#define PG8_WAIT_V(n) asm volatile("s_waitcnt vmcnt(" #n ")" ::: "memory")
#define PG8_WAIT_L(n) asm volatile("s_waitcnt lgkmcnt(" #n ")" ::: "memory")
#define PG8_BAR __builtin_amdgcn_s_barrier()
#define PG8_SCHED __builtin_amdgcn_sched_barrier(0)
    Unit cur, nxt; int ui = 0;
    if (!S.next(0, cur)) return;
    f32x4 acc[2][2][4][2];
#pragma unroll
    for (int a = 0; a < 2; ++a)
#pragma unroll
        for (int b = 0; b < 2; ++b)
#pragma unroll
            for (int m = 0; m < 4; ++m)
#pragma unroll
                for (int n = 0; n < 2; ++n) acc[a][b][m][n] = (f32x4){0.f, 0.f, 0.f, 0.f};
    bf16x8 At[4][2], B0[2][2], B1[2][2];
    const char* cA = (const char*)g.A + (HALFM ? (size_t)(cur.pm & 0xffff) * hstep : (size_t)cur.pm * tstep); const char* cB = (const char*)g.Bt + (size_t)cur.pn * tstep;
    S.a_ready(cur);
    if constexpr (SP2) {
        PG8_STAGE(PG8_SB(0, 0), cB, voffB); PG8_STAGE(PG8_SB(0, 1), cB + hstep, voffB); PG8_STAGE(PG8_SA(0, 0), cA, voffA); PG8_STAGE(PG8_SA(0, 1), cA + hstep, voffA);
        if (wr == 1) PG8_BAR;
        PG8_WAIT_V(2); PG8_BAR;
        PG8_STAGE(PG8_SB(1, 0), cB + kstep, voffB); PG8_STAGE(PG8_SA(1, 0), cA + kstep, voffA); PG8_STAGE(PG8_SB(1, 1), cB + hstep + kstep, voffB);
        PG8_WAIT_V(6); PG8_BAR;
    } else {
        PG8_STAGE(PG8_SB(0, 0), cB, voffB); PG8_STAGE(PG8_SA(0, 0), cA, voffA); PG8_STAGE(PG8_SB(0, 1), cB + hstep, voffB); PG8_STAGE(PG8_SA(0, 1), cA + hstep, voffA);
        if (wr == 1) PG8_BAR;
        PG8_WAIT_V(4); PG8_BAR;
        PG8_STAGE(PG8_SB(1, 0), cB + kstep, voffB); PG8_STAGE(PG8_SA(1, 0), cA + kstep, voffA); PG8_STAGE(PG8_SB(1, 1), cB + hstep + kstep, voffB);
        PG8_WAIT_V(6); PG8_BAR;
    }
    for (;;) {
        const bool has_next = S.next(ui + 1, nxt);
        const char* nA = has_next ? (const char*)g.A + (HALFM ? (size_t)(nxt.pm & 0xffff) * hstep : (size_t)nxt.pm * tstep) : cA;
          const bool full = !HALFM || ((cur.pm >> 17) & 1); const char* nB = has_next ? (const char*)g.Bt + (size_t)nxt.pn * tstep : cB;
        for (int t = 0; t < nt; t += 2) {
            const bool last = (t == nt - 2);
            const char* a1 = cA + (size_t)(t + 1) * kstep;
            const char* a2 = last ? nA : cA + (size_t)(t + 2) * kstep; const char* b2 = last ? nB : cB + (size_t)(t + 2) * kstep;
            const char* a3 = a2 + kstep; const char* b3 = b2 + kstep;
            if (last && has_next) S.a_ready(nxt);
            if constexpr (SP2) {
            PG8_LDB(B0, 0, 0); PG8_LDB(B1, 0, 1); PG8_SCHED; PG8_LDA(At, 0, 0); PG8_STAGE(PG8_SA(1, 1), a1 + hstep, voffA);
            PG8_WAIT_V(8); PG8_WAIT_L(0); PG8_BAR; PG8_MMA(0, 0, At, B0); PG8_MMA(0, 1, At, B1); PG8_BAR; PG8_SCHED;
            PG8_LDA(At, 0, 1); PG8_STAGE(PG8_SB(0, 0), b2, voffB); PG8_STAGE(PG8_SB(0, 1), b2 + hstep, voffB); PG8_STAGE(PG8_SA(0, 0), a2, voffA);
            PG8_WAIT_V(8); PG8_WAIT_L(0); PG8_BAR; if (full) { PG8_MMA(1, 0, At, B0); PG8_MMA(1, 1, At, B1); } PG8_BAR; PG8_SCHED;
            PG8_LDB(B0, 1, 0); PG8_LDB(B1, 1, 1); PG8_SCHED; PG8_LDA(At, 1, 0); PG8_STAGE(PG8_SA(0, 1), a2 + hstep, voffA);
            PG8_WAIT_V(8); PG8_WAIT_L(0); PG8_BAR; PG8_MMA(0, 0, At, B0); PG8_MMA(0, 1, At, B1); PG8_BAR; PG8_SCHED;
            PG8_LDA(At, 1, 1); PG8_STAGE(PG8_SB(1, 0), b3, voffB); PG8_STAGE(PG8_SB(1, 1), b3 + hstep, voffB); PG8_STAGE(PG8_SA(1, 0), a3, voffA);
            PG8_WAIT_V(8); PG8_WAIT_L(0); PG8_BAR; if (full) { PG8_MMA(1, 0, At, B0); PG8_MMA(1, 1, At, B1); } PG8_BAR; PG8_SCHED;
            } else {
            PG8_LDB(B0, 0, 0); PG8_SCHED; PG8_LDA(At, 0, 0); PG8_STAGE(PG8_SA(1, 1), a1 + hstep, voffA);
            PG8_WAIT_L(8); PG8_BAR; PG8_WAIT_L(0); PG8_MMA(0, 0, At, B0); PG8_BAR; PG8_SCHED;
            PG8_LDB(B1, 0, 1); PG8_STAGE(PG8_SB(0, 0), b2, voffB);
            PG8_BAR; PG8_WAIT_L(0); PG8_MMA(0, 1, At, B1); PG8_BAR;
            PG8_LDA(At, 0, 1); PG8_STAGE(PG8_SA(0, 0), a2, voffA);
            PG8_BAR; PG8_WAIT_L(0); PG8_MMA(1, 0, At, B0); PG8_BAR; PG8_SCHED;
            PG8_STAGE(PG8_SB(0, 1), b2 + hstep, voffB);
            PG8_WAIT_V(6); PG8_BAR; PG8_MMA(1, 1, At, B1); PG8_BAR;
            PG8_LDB(B0, 1, 0); PG8_SCHED; PG8_LDA(At, 1, 0); PG8_STAGE(PG8_SA(0, 1), a2 + hstep, voffA);
            PG8_WAIT_L(8); PG8_BAR; PG8_WAIT_L(0); PG8_MMA(0, 0, At, B0); PG8_BAR; PG8_SCHED;
            PG8_LDB(B1, 1, 1); PG8_STAGE(PG8_SB(1, 0), b3, voffB);
            PG8_BAR; PG8_WAIT_L(0); PG8_MMA(0, 1, At, B1); PG8_BAR;
            PG8_LDA(At, 1, 1); PG8_STAGE(PG8_SA(1, 0), a3, voffA);
            PG8_BAR; PG8_WAIT_L(0); PG8_MMA(1, 0, At, B0); PG8_BAR; PG8_SCHED;
            PG8_STAGE(PG8_SB(1, 1), b3 + hstep, voffB);
            PG8_WAIT_V(6); PG8_BAR; PG8_MMA(1, 1, At, B1); PG8_BAR;
            }
        }
        if constexpr (ALIGN_EPI) { if (wr == 0) PG8_BAR; }
        if constexpr (!Epi::AFTER_DRAIN) { E(acc, cur, wr, wc, fr, fq); S.done(cur); }
        if (!has_next) break;
#pragma unroll
        for (int a = 0; a < 2; ++a)
#pragma unroll
            for (int b = 0; b < 2; ++b)
#pragma unroll
                for (int m = 0; m < 4; ++m)
#pragma unroll
                    for (int n = 0; n < 2; ++n) acc[a][b][m][n] = (f32x4){0.f, 0.f, 0.f, 0.f};
        cur = nxt; cA = nA; cB = nB; ++ui;
        if constexpr (ALIGN_EPI) { if (wr == 1) PG8_BAR; }
    }
    PG8_WAIT_V(0);
    if constexpr (!ALIGN_EPI) { if (wr == 0) PG8_BAR; }
    PG8_BAR;
    if constexpr (Epi::AFTER_DRAIN) { E.fused(acc, cur, wr, wc, fr, fq, lds, wid, lane); S.done(cur); }
#undef PG8_SA
#undef PG8_SB
#undef PG8_STAGE
#undef PG8_LDA
#undef PG8_LDB
#undef PG8_MMA
#undef PG8_WAIT_V
#undef PG8_WAIT_L
#undef PG8_BAR
#undef PG8_SCHED
}
}
#ifndef PG8_SP2
#define PG8_SP2 true
#endif
#ifndef PG8_ALIGN
#define PG8_ALIGN true
#endif
#ifndef MK_LAUNCHES
#define MK_LAUNCHES 1
#endif
constexpr int NPHASE = 12;

constexpr int NB = 4, T = 2048, D = 2048, M = NB * T;
constexpr int TC = 256, MC = NB * TC, MA = M + MC;
constexpr int NIN = 9280, NINP = 9472;
constexpr int DXBC = 3072, NH = 32, HD = 64, DST = 128;
constexpr int NE = 32, DFF = 2048, NMOD = 12288;
constexpr int MPMAX = 40960;
constexpr float EPS = 1e-6f;

constexpr size_t MiB = 1u << 20;
constexpr size_t WS_CTL = 0, CTL_ZERO_BYTES = 1 * MiB;
constexpr size_t WS_MOD = 1 * MiB;
constexpr size_t WS_WRT = 2 * MiB;
constexpr size_t WS_ROUTE = 3 * MiB;
constexpr size_t RT_IDX = 0, RT_W = 131072, RT_SLOT = 262144, RT_BCNT = 393216, RT_CUMT = 425984, RT_SW = 430080, RT_ASC = 786432;
constexpr size_t WQ_HN = WS_WRT + 589824;
constexpr size_t WS_DT = 4 * MiB;
constexpr size_t WS_WIN = 8 * MiB;
constexpr size_t WS_WOUT = 46 * MiB;
constexpr size_t WS_WGU = 64 * MiB;
constexpr size_t WS_WD = 576 * MiB;
constexpr size_t WS_HA = 832 * MiB;
constexpr size_t WS_Z = 868 * MiB;
constexpr size_t WS_XBC = 900 * MiB;
constexpr size_t WS_V = 954 * MiB;
constexpr size_t WS_XBCC = 986 * MiB;
constexpr size_t WS_YF = 1040 * MiB, WS_YB = 1072 * MiB;
constexpr size_t WS_YC = 1104 * MiB;
constexpr size_t WS_MIX = 1136 * MiB;
constexpr size_t WS_X1 = 1200 * MiB;
constexpr size_t WS_H2 = 1264 * MiB;
constexpr size_t WS_HS = 1296 * MiB;
constexpr size_t WS_ACT = 1456 * MiB;
constexpr size_t WS_YS = 1616 * MiB;
constexpr size_t WS_H2Q = 1776 * MiB;
constexpr size_t WS_END = 1792 * MiB;
constexpr size_t WQ_HSC = WS_WRT + 262144, WQ_WSC = WS_WRT + 327680, WQ_SSA = WS_WRT + 393216;
constexpr size_t WQ_HASC = WS_WRT + 720896;
constexpr size_t WQ_MSC = WS_WRT + 655360;
constexpr float WQ_CLIP = 4.2f;
constexpr int CW_BAR = 4096;
static_assert(RT_SW + (size_t)MPMAX * 4 <= RT_ASC && RT_ASC + (size_t)MPMAX * 4 <= MiB, "route region");

constexpr int TAB_OFF = 160768;
constexpr int LDS_BYTES = 163840;

#define GAS __attribute__((address_space(1)))
#define LAS __attribute__((address_space(3)))
typedef unsigned short bf16;
typedef unsigned v4u __attribute__((ext_vector_type(4)));
typedef unsigned v2u __attribute__((ext_vector_type(2)));
typedef float f4 __attribute__((ext_vector_type(4)));
typedef float f2 __attribute__((ext_vector_type(2)));
typedef float f16v __attribute__((ext_vector_type(16)));
typedef short h8 __attribute__((ext_vector_type(8)));
typedef short h4 __attribute__((ext_vector_type(4)));
typedef __bf16 bfv2 __attribute__((ext_vector_type(2)));
#define LDS_WAIT() asm volatile("s_waitcnt lgkmcnt(0)" ::: "memory")
#define VM_WAIT() asm volatile("s_waitcnt vmcnt(0)" ::: "memory")
__device__ __forceinline__ unsigned pk2(float lo, float hi) { f2 v = {lo, hi}; return __builtin_bit_cast(unsigned, __builtin_convertvector(v, bfv2)); }
__device__ __forceinline__ float bflo(unsigned u) { return __uint_as_float(u << 16); }
__device__ __forceinline__ float bfhi(unsigned u) { return __uint_as_float(u & 0xffff0000u); }
__device__ __forceinline__ float bf1(bf16 u) { return __uint_as_float(((unsigned)u) << 16); }
__device__ __forceinline__ float wave_sum(float v) {
#pragma unroll
    for (int o = 1; o < 64; o <<= 1) v += __shfl_xor(v, o);
    return v;
}
__device__ __forceinline__ float sigm(float x) { return __builtin_amdgcn_rcpf(1.0f + __expf(-x)); }
__device__ __forceinline__ float siluf(float x) { return x * __builtin_amdgcn_rcpf(1.0f + __expf(-x)); }
__device__ __forceinline__ void unpack8(const v4u u, float (&f)[8]) { f[0] = bflo(u.x); f[1] = bfhi(u.x); f[2] = bflo(u.y); f[3] = bfhi(u.y); f[4] = bflo(u.z); f[5] = bfhi(u.z); f[6] = bflo(u.w); f[7] = bfhi(u.w); }
__device__ __forceinline__ v4u pack8(const float (&f)[8]) { v4u o; o.x = pk2(f[0], f[1]); o.y = pk2(f[2], f[3]); o.z = pk2(f[4], f[5]); o.w = pk2(f[6], f[7]); return o; }
__device__ __forceinline__ unsigned q8x4(float a, float b, float c, float d) {
    const unsigned ua = __float_as_uint(__builtin_amdgcn_fmed3f(a, -127.f, 127.f) + 12582912.f), ub = __float_as_uint(__builtin_amdgcn_fmed3f(b, -127.f, 127.f) + 12582912.f),
                   uc = __float_as_uint(__builtin_amdgcn_fmed3f(c, -127.f, 127.f) + 12582912.f), ud = __float_as_uint(__builtin_amdgcn_fmed3f(d, -127.f, 127.f) + 12582912.f);
    return (ua & 0xffu) | ((ub & 0xffu) << 8) | ((uc & 0xffu) << 16) | (ud << 24);
}
__device__ __forceinline__ unsigned pack4b(float a, float b, float c, float d) {
    return __builtin_amdgcn_perm(__builtin_amdgcn_perm(__float_as_uint(d), __float_as_uint(c), 0x0c0c0400u), __builtin_amdgcn_perm(__float_as_uint(b), __float_as_uint(a), 0x0c0c0400u), 0x05040100u);
}
#define XB_TMO      128
#define XB_XCNT(j)  (256  + 64 * (j))
#define XB_XSUB(j)  (1280 + 64 * (j))
#define XB_XGEN(j)  (2304 + 64 * (j))
#define XB_TOP      3328
#define XB_TOPGEN   3392
#define XCD_BAR_WORDS 3456
#define XB_SPIN_CAP (1u << 18)

__device__ __forceinline__ unsigned xb_ld(unsigned* p)              { return __hip_atomic_load(p, __ATOMIC_RELAXED, __HIP_MEMORY_SCOPE_AGENT); }
__device__ __forceinline__ unsigned xb_add(unsigned* p, unsigned v) { return __hip_atomic_fetch_add(p, v, __ATOMIC_RELAXED, __HIP_MEMORY_SCOPE_AGENT); }
__device__ __forceinline__ unsigned xb_xcc_id() { return (unsigned)__builtin_amdgcn_s_getreg((3 << 11) | 20) & 0xFu; }
#define XB_SPIN(cond, bar) do { unsigned _sp = 0; while (cond) { __builtin_amdgcn_s_sleep(1); \
    if ((++_sp & 255u) == 0u) { if (xb_ld(&(bar)[XB_TMO])) break; if (_sp > XB_SPIN_CAP) { atomicAdd(&(bar)[XB_TMO], 1u); break; } } } } while (0)

struct XcdBarrier {
    unsigned* bar; unsigned x;
    volatile LAS unsigned* st;
};

__device__ __forceinline__ XcdBarrier xcd_barrier_post(unsigned* bar, volatile LAS unsigned* st) {
    XcdBarrier b; b.bar = bar; b.x = xb_xcc_id(); b.st = st;
    if (threadIdx.x == 0) (void)xb_add(&bar[XB_XCNT(b.x)], 1u);
    return b;
}
__device__ __forceinline__ void xcd_barrier_complete(unsigned* bar, unsigned x, unsigned& nloc, unsigned& nx) {
    const unsigned G = gridDim.x * gridDim.y * gridDim.z;
    unsigned sum, cnt, mine, sp = 0u;
    for (;;) {
        sum = 0u; cnt = 0u; mine = 0u;
#pragma unroll
        for (unsigned j = 0; j < 16; ++j) { const unsigned c = xb_ld(&bar[XB_XCNT(j)]); sum += c; cnt += (c > 0u) ? 1u : 0u; mine = (j == x) ? c : mine; }
        if (sum == G) break;
        __builtin_amdgcn_s_sleep(1);
        if ((++sp & 255u) == 0u) { if (xb_ld(&bar[XB_TMO])) break; if (sp > XB_SPIN_CAP) { atomicAdd(&bar[XB_TMO], 1u); break; } }
    }
    nloc = mine > 0u ? mine : 1u; nx = cnt > 0u ? cnt : 1u;
}

__device__ __forceinline__ void xcd_barrier(const XcdBarrier& b) {
    asm volatile("s_waitcnt vmcnt(0)" ::: "memory");
    __syncthreads();
    if (threadIdx.x == 0) {
        unsigned* bar = b.bar;
        __builtin_amdgcn_s_waitcnt(0);
        unsigned nloc = b.st[0], nx = b.st[1];
        if (nloc == 0u) { xcd_barrier_complete(bar, b.x, nloc, nx); b.st[0] = nloc; b.st[1] = nx; }
        const unsigned old = xb_add(&bar[XB_XSUB(b.x)], 1u);
        const unsigned gen = old / nloc;
        if (old + 1u == (gen + 1u) * nloc) {
            __builtin_amdgcn_fence(__ATOMIC_RELEASE, "agent");
            asm volatile("s_waitcnt vmcnt(0)" ::: "memory");
            const unsigned og = xb_add(&bar[XB_TOP], 1u);
            const unsigned tg = og / nx;
            if (og + 1u == (tg + 1u) * nx) xb_add(&bar[XB_TOPGEN], 1u);
            else XB_SPIN(xb_ld(&bar[XB_TOPGEN]) == tg, bar);
            __builtin_amdgcn_fence(__ATOMIC_ACQUIRE, "agent");
            xb_add(&bar[XB_XGEN(b.x)], 1u);
            asm volatile("s_waitcnt vmcnt(0)" ::: "memory");
        } else {
            XB_SPIN(xb_ld(&bar[XB_XGEN(b.x)]) == gen, bar);
            __builtin_amdgcn_fence(__ATOMIC_ACQUIRE, "agent");
            asm volatile("s_waitcnt vmcnt(0)" ::: "memory");
        }
    }
    __syncthreads();
}
struct Args { const float* in[29]; float* out; unsigned char* ws; int ph_lo, ph_hi; int li, pad; };
typedef const __attribute__((address_space(4))) Args CArgs;
enum { I_X = 0, I_C, I_CTX, I_CCTX, I_WMOD, I_BMOD, I_GMIX, I_GFFN, I_WIN, I_SCW, I_SCB, I_ALF, I_DBF, I_ALB, I_DBB, I_DSKIP, I_SNG,
       I_CDW, I_CDB, I_CLG, I_CLB, I_WOUT, I_WR, I_BR, I_WGU, I_BGU, I_WD, I_BD, I_GFIN };

struct InProjOrder {
    pg8::StaticOrder so; int G, c, i0, i1;
    __device__ __forceinline__ void init(int G_, int c_) { so.init(M, NINP, G_, c_); G = G_; c = c_; i0 = 0; i1 = 1 << 20; }
    __device__ __forceinline__ bool next(int ii, pg8::Unit& u) const {
        const int i = ii + i0; if (i >= i1) return false;
        const int L = i * G + c;
        if (L < 1184) return so.next(i, u);
        const int r = L - 1184; if (r >= 52) return false;
        const int q = r >> 2; u.pm = 32 + (r & 3); u.pn = q < 12 ? 8 + q : 36; return true;
    }
    __device__ __forceinline__ void a_ready(const pg8::Unit&) const {}
    __device__ __forceinline__ void done(const pg8::Unit&) const {}
};
struct EpiInProj {
    static constexpr bool PERM = true, AFTER_DRAIN = false;
    bf16* Z; bf16* XBC; bf16* V; float* DT; const float* hsc; const float* wsc;
    __device__ __forceinline__ void operator()(const pg8::f32x4 (&acc)[2][2][4][2], const pg8::Unit& u, int wr, int wc, int fr, int fq) const {
        const int row0 = u.pm * 256 + wr * 64 + fr, pn = u.pn; const float ws = wsc[32];
#define IPV4(ai, bj, m, n) (__builtin_convertvector(__builtin_bit_cast(pg8::i32x4, acc[ai][bj][m][n]), pg8::f32x4) * sc)
        if (pn < 20) {
            bf16* base; int ldc, colt;
            if (pn < 8) { base = Z; ldc = 2048; colt = pn * 256; } else { base = XBC; ldc = DXBC; colt = (pn - 8) * 256; }
            const int col0 = colt + wc * 32 + 8 * fq;
#pragma unroll
            for (int ai = 0; ai < 2; ++ai)
#pragma unroll
                for (int m = 0; m < 4; ++m) { const int row = row0 + ai * 128 + m * 16; const float sc = hsc[row] * ws; bf16* rowp = base + (size_t)row * ldc + col0;
#pragma unroll
                    for (int bj = 0; bj < 2; ++bj) { const pg8::f32x4 v0 = IPV4(ai, bj, m, 0), v1 = IPV4(ai, bj, m, 1);
                        v4u w; w.x = pk2(v0[0], v0[1]); w.y = pk2(v0[2], v0[3]); w.z = pk2(v1[0], v1[1]); w.w = pk2(v1[2], v1[3]);
                        *(v4u*)(rowp + bj * 128) = w; } }
        } else if (pn < 36) {
            const int col0 = (pn - 20) * 128 + wc * 32 + 8 * fq;
#pragma unroll
            for (int ai = 0; ai < 2; ++ai)
#pragma unroll
                for (int m = 0; m < 4; ++m) { const int row = row0 + ai * 128 + m * 16; const float sc = hsc[row] * ws; bf16* rowp = V + (size_t)row * 2048 + col0;
                    float o[8];
#pragma unroll
                    for (int n = 0; n < 2; ++n) { const pg8::f32x4 av = IPV4(ai, 0, m, n), tv = IPV4(ai, 1, m, n) * (-1.44269504f);
                        const pg8::f32x4 den = (pg8::f32x4){__builtin_amdgcn_exp2f(tv[0]), __builtin_amdgcn_exp2f(tv[1]), __builtin_amdgcn_exp2f(tv[2]), __builtin_amdgcn_exp2f(tv[3])} + 1.0f;
                        const pg8::f32x4 ov = av * (pg8::f32x4){__builtin_amdgcn_rcpf(den[0]), __builtin_amdgcn_rcpf(den[1]), __builtin_amdgcn_rcpf(den[2]), __builtin_amdgcn_rcpf(den[3])};
#pragma unroll
                        for (int i = 0; i < 4; ++i) o[4 * n + i] = ov[i]; }
                    *(v4u*)rowp = pack8(o); }
        } else {
            if (wc < 2) {
#pragma unroll
                for (int ai = 0; ai < 2; ++ai)
#pragma unroll
                    for (int m = 0; m < 4; ++m) { const int row = row0 + ai * 128 + m * 16; const float sc = hsc[row] * ws; float* rowp = DT + (size_t)row * 64 + wc * 32 + 8 * fq;
                        *(pg8::f32x4*)rowp = IPV4(ai, 0, m, 0); *(pg8::f32x4*)(rowp + 4) = IPV4(ai, 0, m, 1); }
            }
        }
#undef IPV4
    }
};
struct EpiOutProj {
    static constexpr bool PERM = false, AFTER_DRAIN = false;
    const float* x; const float* mod; float* X1;
    __device__ __forceinline__ void operator()(const pg8::f32x4 (&acc)[2][2][4][2], const pg8::Unit& u, int wr, int wc, int fr, int fq) const {
        const int row0 = u.pm * 256 + wr * 64 + fr, col0 = u.pn * 256 + wc * 32 + 4 * fq;
        const float* gm = mod + (size_t)(u.pm >> 3) * NMOD + 4096 + col0;
        pg8::f32x4 gv[2][2];
#pragma unroll
        for (int bj = 0; bj < 2; ++bj)
#pragma unroll
            for (int n = 0; n < 2; ++n) gv[bj][n] = *(const pg8::f32x4*)(gm + bj * 128 + n * 16);
#pragma unroll
        for (int ai = 0; ai < 2; ++ai)
#pragma unroll
            for (int m = 0; m < 4; ++m) { const size_t off = (size_t)(row0 + ai * 128 + m * 16) * 2048 + col0;
#pragma unroll
                for (int bj = 0; bj < 2; ++bj)
#pragma unroll
                    for (int n = 0; n < 2; ++n) { const pg8::f32x4 xv = *(const pg8::f32x4*)(x + off + bj * 128 + n * 16);
                        *(pg8::f32x4*)(X1 + off + bj * 128 + n * 16) = xv + gv[bj][n] * acc[ai][bj][m][n]; } }
    }
};
struct MoeOrder {
    const LAS int* tab; int nN, G, c; int i0 = 0, i1 = 1 << 20;
    __device__ __forceinline__ bool next(int i, pg8::Unit& u) const {
        const int NF = tab[32] * nN, NH = tab[66] * nN, nwg = NF + NH, L = (i + i0) * G + c;
        if (i + i0 >= i1 || L >= nwg) return false;
        const int q = nwg / 8, r = nwg % 8, xcd = L % 8, off = L / 8;
        const int qbase = (xcd < r ? xcd * (q + 1) : r * (q + 1) + (xcd - r) * q), qx = q + (xcd < r ? 1 : 0);
        const int hbase = (NH * xcd) / 8, nhx = (NH * (xcd + 1)) / 8 - hbase, nfx = qx - nhx;
        const int ln = (int)__builtin_amdgcn_mbcnt_hi(~0u, __builtin_amdgcn_mbcnt_lo(~0u, 0u)), cj = tab[ln < 32 ? ln : 32], hj = tab[33 + (ln < 32 ? ln : 32)];
        int e, pm, pnl;
        if (off < nfx) {
            const int F = qbase - hbase + off;
            e = __builtin_popcountll(__ballot(ln < 32 && F >= cj * nN)) - 1;
            const int f0 = __shfl(cj, e), fe = __shfl(cj, e + 1) - f0, v = F - f0 * nN;
            pm = (__shfl(hj, e) + 2 * (v % fe)) | (3 << 16); pnl = v / fe;
        } else {
            const int Hh = hbase + (off - nfx), k = Hh / nN;
            e = tab[67 + k]; pnl = Hh % nN;
            pm = (__shfl(hj, e + 1) - 1) | (1 << 16);
        }
        u.pm = __builtin_amdgcn_readfirstlane(pm); u.pn = __builtin_amdgcn_readfirstlane(e * nN + pnl); return true;
    }
    __device__ __forceinline__ void a_ready(const pg8::Unit&) const {}
    __device__ __forceinline__ void done(const pg8::Unit&) const {}
};
struct EpiGateUp {
    static constexpr bool PERM = true, AFTER_DRAIN = false;
    const float* bgu; const float* ssa; const float* wsc; const float* asc; unsigned char* ACT;
    __device__ __forceinline__ void operator()(const pg8::f32x4 (&acc)[2][2][4][2], const pg8::Unit& u, int wr, int wc, int fr, int fq) const {
        const int e = u.pn >> 4, j = u.pn & 15, row0 = (u.pm & 0xffff) * 128 + wr * 64 + fr, col0 = j * 128 + wc * 32 + 8 * fq; const bool full = (u.pm >> 17) & 1;
        const float* bp = bgu + (size_t)e * 4096 + col0; const float ws = wsc[e];
        const pg8::f32x4 bg0 = *(const pg8::f32x4*)bp, bg1 = *(const pg8::f32x4*)(bp + 4), bl0 = *(const pg8::f32x4*)(bp + 2048), bl1 = *(const pg8::f32x4*)(bp + 2052);
#pragma unroll
        for (int ai = 0; ai < 2; ++ai) if (ai == 0 || full)
#pragma unroll
            for (int m = 0; m < 4; ++m) { const int row = row0 + ai * 128 + m * 16; const float sc = ssa[row] * ws; const float as = asc[row], ainv = as > 0.f ? 1.0f / as : 0.f; unsigned char* rowp = ACT + (size_t)row * 2048 + col0;
                float o[8];
#pragma unroll
                for (int n = 0; n < 2; ++n) { const pg8::i32x4 ig = __builtin_bit_cast(pg8::i32x4, acc[ai][0][m][n]), il = __builtin_bit_cast(pg8::i32x4, acc[ai][1][m][n]);
                    const pg8::f32x4 bgv = n ? bg1 : bg0, blv = n ? bl1 : bl0;
#pragma unroll
                    for (int h = 0; h < 2; ++h) {
                        f2 g = (f2){(float)ig[2 * h], (float)ig[2 * h + 1]} * sc + (f2){bgv[2 * h], bgv[2 * h + 1]};
                        f2 l = (f2){(float)il[2 * h], (float)il[2 * h + 1]} * sc + (f2){blv[2 * h], blv[2 * h + 1]};
                        g = (f2){fminf(g.x, 7.0f), fminf(g.y, 7.0f)}; l = (f2){__builtin_amdgcn_fmed3f(l.x, -7.0f, 7.0f), __builtin_amdgcn_fmed3f(l.y, -7.0f, 7.0f)};
                        const f2 t = g * (-1.702f * 1.44269504f);
                        const f2 den = (f2){__builtin_amdgcn_exp2f(t.x), __builtin_amdgcn_exp2f(t.y)} + 1.0f;
                        const f2 r = {__builtin_amdgcn_rcpf(den.x), __builtin_amdgcn_rcpf(den.y)};
                        const f2 o2 = (g * r) * (l * ainv + ainv);
                        const f2 q2 = (f2){__builtin_amdgcn_fmed3f(o2.x, -127.f, 127.f), __builtin_amdgcn_fmed3f(o2.y, -127.f, 127.f)} + 12582912.f;
                        o[4 * n + 2 * h] = q2.x; o[4 * n + 2 * h + 1] = q2.y; } }
                v2u qv; qv.x = pack4b(o[0], o[1], o[2], o[3]); qv.y = pack4b(o[4], o[5], o[6], o[7]); *(v2u*)rowp = qv; }
    }
};
struct EpiDown {
    static constexpr bool PERM = true, AFTER_DRAIN = false;
    const float* bd; const float* sw; const float* asc; const float* wsc; bf16* YS;
    __device__ __forceinline__ void operator()(const pg8::f32x4 (&acc)[2][2][4][2], const pg8::Unit& u, int wr, int wc, int fr, int fq) const {
        const int e = u.pn >> 3, j = u.pn & 7, row0 = (u.pm & 0xffff) * 128 + wr * 64 + fr, col0 = j * 256 + wc * 32 + 8 * fq; const bool full = (u.pm >> 17) & 1;
        const float* bp = bd + (size_t)e * 2048 + col0; const float ws = wsc[64 + e];
        pg8::f32x4 bv[2][2];
#pragma unroll
        for (int bj = 0; bj < 2; ++bj)
#pragma unroll
            for (int n = 0; n < 2; ++n) bv[bj][n] = *(const pg8::f32x4*)(bp + bj * 128 + 4 * n);
#pragma unroll
        for (int ai = 0; ai < 2; ++ai) if (ai == 0 || full)
#pragma unroll
            for (int m = 0; m < 4; ++m) { const int row = row0 + ai * 128 + m * 16; const float wt = sw[row], sc = asc[row] * ws; bf16* rowp = YS + (size_t)row * 2048 + col0;
#pragma unroll
                for (int bj = 0; bj < 2; ++bj) { const pg8::i32x4 i0 = __builtin_bit_cast(pg8::i32x4, acc[ai][bj][m][0]), i1 = __builtin_bit_cast(pg8::i32x4, acc[ai][bj][m][1]);
                    const pg8::f32x4 v0 = ((pg8::f32x4){(float)i0[0], (float)i0[1], (float)i0[2], (float)i0[3]} * sc + bv[bj][0]) * wt, v1 = ((pg8::f32x4){(float)i1[0], (float)i1[1], (float)i1[2], (float)i1[3]} * sc + bv[bj][1]) * wt;
                    v4u w; w.x = pk2(v0[0], v0[1]); w.y = pk2(v0[2], v0[3]); w.z = pk2(v1[0], v1[1]); w.w = pk2(v1[2], v1[3]);
                    *(v4u*)(rowp + bj * 128) = w; } }
    }
};
__device__ __forceinline__ void tr_item_q(const float* __restrict__ W, int N, unsigned char* __restrict__ WT, int Kb, int k0, int n0, int drow0, float inv, LAS float* scr, int lane) {
    const float* src = W + (size_t)k0 * N + n0 + lane;
    float v[64];
#pragma unroll
    for (int i = 0; i < 64; ++i) v[i] = src[(size_t)i * N];
#pragma unroll
    for (int i = 0; i < 64; ++i) scr[i * 65 + lane] = v[i];
    LDS_WAIT();
#pragma unroll
    for (int j = 0; j < 4; ++j) { const int n = (lane >> 2) + 16 * j; const LAS float* q = scr + (16 * (lane & 3)) * 65 + n;
        v4u o; o.x = q8x4(q[0 * 65] * inv, q[1 * 65] * inv, q[2 * 65] * inv, q[3 * 65] * inv); o.y = q8x4(q[4 * 65] * inv, q[5 * 65] * inv, q[6 * 65] * inv, q[7 * 65] * inv);
        o.z = q8x4(q[8 * 65] * inv, q[9 * 65] * inv, q[10 * 65] * inv, q[11 * 65] * inv); o.w = q8x4(q[12 * 65] * inv, q[13 * 65] * inv, q[14 * 65] * inv, q[15 * 65] * inv);
        *(v4u*)(WT + (size_t)(drow0 + n) * Kb + k0 + 16 * (lane & 3)) = o; }
    LDS_WAIT();
}
template <bool NT>
__device__ __forceinline__ void tr_item(const float* __restrict__ W, int N, bf16* __restrict__ WT, int K, int k0, int n0, int drow0, LAS float* scr, int lane) {
    const float* src = W + (size_t)k0 * N + n0 + lane;
    float v[64];
#pragma unroll
    for (int i = 0; i < 64; ++i) v[i] = NT ? __builtin_nontemporal_load(src + (size_t)i * N) : src[(size_t)i * N];
#pragma unroll
    for (int i = 0; i < 64; ++i) scr[i * 65 + lane] = v[i];
    LDS_WAIT();
    const int c = lane & 7;
#pragma unroll
    for (int j = 0; j < 8; ++j) { const int n = (lane >> 3) + 8 * j; const LAS float* s = scr + (8 * c) * 65 + n;
        v4u o; o.x = pk2(s[0 * 65], s[1 * 65]); o.y = pk2(s[2 * 65], s[3 * 65]); o.z = pk2(s[4 * 65], s[5 * 65]); o.w = pk2(s[6 * 65], s[7 * 65]);
        v4u* dst = (v4u*)(WT + (size_t)(drow0 + n) * K + k0 + 8 * c);
        if (NT) __builtin_nontemporal_store(o, dst); else *dst = o; }
    LDS_WAIT();
}
__device__ __forceinline__ int win_drow(int n0) {
    if (n0 < 5120) return n0;
    if (n0 < 5184) return 9216 + (n0 - 5120);
    if (n0 < 7232) { const int j = n0 - 5184; return (20 + (j >> 7)) * 256 + (j & 127); }
    const int j = n0 - 7232; return (20 + (j >> 7)) * 256 + 128 + (j & 127);
}
__device__ __forceinline__ int gu_drow(int n0) { if (n0 < 2048) return (n0 >> 7) * 256 + (n0 & 127); const int j = n0 - 2048; return (j >> 7) * 256 + 128 + (j & 127); }
constexpr int CV_SCR = 16896;
constexpr int IT_OUT = 64 * 32, IT_GU = 32 * 64 * 32, IT_D = 32 * 32 * 32, NIT_B = IT_GU + IT_D, IT_P4 = IT_GU / 4  ;
struct CvItem { const float* src; unsigned char* dst; int N; float inv, lim; };
__device__ __forceinline__ CvItem conv_decode(CArgs& A, int it) {
    unsigned char* ws = A.ws; int r = it; CvItem c;
    if (r < IT_GU) { const int e = r >> 11, rr = r & 2047, kb = rr >> 7, nb = rr & 127; c.N = 4096; { const float sc_ = ((const float*)(ws + WQ_WSC))[e]; c.inv = 1.0f / sc_; c.lim = 127.0f * sc_; }
        c.src = A.in[I_WGU] + (size_t)e * 2048 * 4096 + (size_t)(128 * kb) * 4096 + 32 * nb; c.dst = ws + WS_WGU + (size_t)e * 4096 * 2048 + (size_t)gu_drow(32 * nb) * 2048 + 128 * kb; return c; }
    r -= IT_GU;
    { const int e = r >> 10, rr = r & 1023, kb = rr >> 6, nb = rr & 63; c.N = 2048; { const float sc_ = ((const float*)(ws + WQ_WSC))[64 + e]; c.inv = 1.0f / sc_; c.lim = 127.0f * sc_; }
        c.src = A.in[I_WD] + (size_t)e * 2048 * 2048 + (size_t)(128 * kb) * 2048 + 32 * nb; c.dst = ws + WS_WD + (size_t)e * 2048 * 2048 + (size_t)(32 * nb) * 2048 + 128 * kb; }
    return c;
}
__device__ __forceinline__ unsigned q8x4c(float a, float b, float c, float d, float lim, float inv) {
    const unsigned ua = __float_as_uint(__builtin_fmaf(__builtin_amdgcn_fmed3f(a, -lim, lim), inv, 12582912.f)), ub = __float_as_uint(__builtin_fmaf(__builtin_amdgcn_fmed3f(b, -lim, lim), inv, 12582912.f)),
                   uc = __float_as_uint(__builtin_fmaf(__builtin_amdgcn_fmed3f(c, -lim, lim), inv, 12582912.f)), ud = __float_as_uint(__builtin_fmaf(__builtin_amdgcn_fmed3f(d, -lim, lim), inv, 12582912.f));
    return __builtin_amdgcn_perm(__builtin_amdgcn_perm(ud, uc, 0x0c0c0400u), __builtin_amdgcn_perm(ub, ua, 0x0c0c0400u), 0x05040100u);
}
#define CV_LOAD(v, c) do { const float* s_ = (c).src + (size_t)(16 * (lane >> 3)) * (c).N + 4 * (lane & 7); _Pragma("unroll") for (int i_ = 0; i_ < 16; ++i_) (v)[i_] = __builtin_nontemporal_load((const f4*)(s_ + (size_t)i_ * (c).N)); } while (0)
#define CV_FINISH(v, c) do { const float iv_ = (c).inv, lm_ = (c).lim; unsigned char* d_ = (c).dst + (size_t)(4 * (lane & 7)) * 2048 + 16 * (lane >> 3); \
        _Pragma("unroll") for (int j_ = 0; j_ < 4; ++j_) { v4u o_; \
            o_.x = q8x4c((v)[0][j_], (v)[1][j_], (v)[2][j_], (v)[3][j_], lm_, iv_); o_.y = q8x4c((v)[4][j_], (v)[5][j_], (v)[6][j_], (v)[7][j_], lm_, iv_); \
            o_.z = q8x4c((v)[8][j_], (v)[9][j_], (v)[10][j_], (v)[11][j_], lm_, iv_); o_.w = q8x4c((v)[12][j_], (v)[13][j_], (v)[14][j_], (v)[15][j_], lm_, iv_); \
            __builtin_nontemporal_store(o_, (v4u*)(d_ + (size_t)j_ * 2048)); } } while (0)
__device__ __forceinline__ void conv_static(CArgs& A, int begin, int end, int rank, int nrank, LAS unsigned char* lds, int lane, int wave) {
    (void)lds; (void)wave;
    int it = begin + rank; if (it >= end) return;
    f4 va[16], vb[16];
    CvItem ca = conv_decode(A, it), cb = ca;
    CV_LOAD(va, ca);
#pragma unroll 1
    for (;;) {
        it += nrank; const bool more_b = it < end;
        if (more_b) { cb = conv_decode(A, it); CV_LOAD(vb, cb); }
        CV_FINISH(va, ca);
        if (!more_b) break;
        it += nrank; const bool more_a = it < end;
        if (more_a) { ca = conv_decode(A, it); CV_LOAD(va, ca); }
        CV_FINISH(vb, cb);
        if (!more_a) break;
    }
}

__device__ __forceinline__ void conv_simple(CArgs& A, int begin, int end, int rank, int nrank, int lane) {
#pragma unroll 1
    for (int it = begin + rank; it < end; it += nrank) { const CvItem c = conv_decode(A, it); f4 va[16]; CV_LOAD(va, c); CV_FINISH(va, c); }
}

__device__ __forceinline__ void p0_prologue(CArgs& A, LAS unsigned char* lds, int tid, int lane, int wave, int bx, int G) {
    unsigned char* ws = A.ws;
    if (bx < 32 && wave == 7) { const float* w = A.in[I_WGU] + (size_t)bx * 2048 * 4096 + lane; float ss = 0.f;
#pragma unroll
        for (int i = 0; i < 64; ++i) { const float v = w[(size_t)i * 4096]; ss += v * v; }
        ss = wave_sum(ss); if (lane == 0) ((float*)(ws + WQ_WSC))[bx] = WQ_CLIP * sqrtf(ss * (1.0f / 4096.0f)) * (1.0f / 127.0f); }
    if (bx < 32 && wave == 5) { const float* w = A.in[I_WD] + (size_t)bx * 2048 * 2048 + lane; float ss = 0.f;
#pragma unroll
        for (int i = 0; i < 64; ++i) { const float v = w[(size_t)i * 2048]; ss += v * v; }
        ss = wave_sum(ss); if (lane == 0) ((float*)(ws + WQ_WSC))[64 + bx] = WQ_CLIP * sqrtf(ss * (1.0f / 4096.0f)) * (1.0f / 127.0f); }
    if (bx == 32 && wave == 5) { const float* w = A.in[I_WOUT] + lane; float ss = 0.f;
#pragma unroll
        for (int i = 0; i < 64; ++i) { const float v = w[(size_t)i * 2048]; ss += v * v; }
        ss = wave_sum(ss); if (lane == 0) ((float*)(ws + WQ_WSC))[33] = WQ_CLIP * sqrtf(ss * (1.0f / 4096.0f)) * (1.0f / 127.0f); }
    if (bx == 0 && wave == 6) { const float* w = A.in[I_WIN] + lane; float ss = 0.f;
#pragma unroll
        for (int i = 0; i < 64; ++i) { const float v = w[(size_t)i * NIN]; ss += v * v; }
        ss = wave_sum(ss); const float sc = WQ_CLIP * sqrtf(ss * (1.0f / 4096.0f)) * (1.0f / 127.0f);
        if (lane == 0 && bx == 0) ((float*)(ws + WQ_WSC))[32] = sc; }
    LAS float* st = (LAS float*)lds;
    LAS float* part = (LAS float*)(lds + 40960);
    for (int i = tid; i < 5 * 2048; i += 512) { const int r = i >> 11, k = i & 2047; const float v = r < 4 ? A.in[I_C][r * 2048 + k] : A.in[I_CCTX][k]; st[i] = v / (1.0f + __expf(-v)); }
    __syncthreads();
    for (int cb = bx; cb < 192; cb += G) {
        const int n0 = 64 * cb, k0 = 256 * wave;
        float acc[5] = {0.f, 0.f, 0.f, 0.f, 0.f};
        const float* wp = A.in[I_WMOD] + (size_t)k0 * NMOD + n0 + lane;
#pragma unroll 1
        for (int kk = 0; kk < 256; kk += 32) {
            float wv[32];
#pragma unroll
            for (int u = 0; u < 32; ++u) wv[u] = __builtin_nontemporal_load(wp + (size_t)(kk + u) * NMOD);
#pragma unroll
            for (int u = 0; u < 32; ++u)
#pragma unroll
                for (int r = 0; r < 5; ++r) acc[r] += st[r * 2048 + k0 + kk + u] * wv[u];
        }
#pragma unroll
        for (int r = 0; r < 5; ++r) part[(wave * 5 + r) * 64 + lane] = acc[r];
        __syncthreads();
        if (tid < 320) { const int r = tid >> 6, ln = tid & 63; float s = A.in[I_BMOD][n0 + ln];
#pragma unroll
            for (int w = 0; w < 8; ++w) s += part[(w * 5 + r) * 64 + ln];
            ((float*)(ws + WS_MOD))[r * NMOD + n0 + ln] = s; }
        __syncthreads();
    }
    { bf16* hi = (bf16*)(ws + WS_WRT); bf16* lo = hi + 65536; const float* wr = A.in[I_WR];
      for (int i = bx * 512 + tid; i < 65536; i += G * 512) { const int e = i >> 11, k = i & 2047; const float v = wr[k * 32 + e];
          const unsigned h = pk2(v, 0.f) & 0xffffu; const float r = v - __uint_as_float(h << 16); hi[i] = (bf16)h; lo[i] = (bf16)(pk2(r, 0.f) & 0xffffu); } }
    { v4u* z = (v4u*)(ws + WS_WIN + (size_t)NIN * 2048); const v4u zero = {0u, 0u, 0u, 0u};
      for (int i = bx * 512 + tid; i < 24576; i += G * 512) z[i] = zero; }
    __syncthreads();
}

__device__ __forceinline__ void p1_norm(CArgs& A, LAS unsigned char* lds, int lane, int wave, int bx, int G) {
    const float* mod = (const float*)(A.ws + WS_MOD); unsigned char* HA = A.ws + WS_HA; float* hsc = (float*)(A.ws + WQ_HASC); const float* gmix = A.in[I_GMIX];
#pragma unroll 1
    for (int row = bx * 8 + wave; row < MA; row += G * 8) {
        const float* src; const float* sh;
        if (row < M) { src = A.in[I_X] + (size_t)row * D; sh = mod + (size_t)(row >> 11) * NMOD; } else { src = A.in[I_CTX] + (size_t)(row - M) * D; sh = mod + (size_t)4 * NMOD; }
        const float* sc = sh + 2048;
        f4 v[4][2]; float ss = 0.f;
#pragma unroll
        for (int j = 0; j < 4; ++j) { const int c = 8 * lane + 512 * j; v[j][0] = *(const f4*)(src + c); v[j][1] = *(const f4*)(src + c + 4);
            ss += (v[j][0].x * v[j][0].x + v[j][0].y * v[j][0].y) + (v[j][0].z * v[j][0].z + v[j][0].w * v[j][0].w) + (v[j][1].x * v[j][1].x + v[j][1].y * v[j][1].y) + (v[j][1].z * v[j][1].z + v[j][1].w * v[j][1].w); }
        const float rstd = 1.0f / sqrtf(wave_sum(ss) * (1.0f / D) + EPS);
        float amax = 0.f;
#pragma unroll
        for (int j = 0; j < 4; ++j) { const int c = 8 * lane + 512 * j;
#pragma unroll
            for (int q = 0; q < 2; ++q) { const f4 g = *(const f4*)(gmix + c + 4 * q), s = *(const f4*)(sc + c + 4 * q), h = *(const f4*)(sh + c + 4 * q);
#pragma unroll
                for (int i = 0; i < 4; ++i) { const float o = v[j][q][i] * rstd * g[i] * (1.0f + s[i]) + h[i]; v[j][q][i] = o; amax = fmaxf(amax, fabsf(o)); } } }
#pragma unroll
        for (int o = 1; o < 64; o <<= 1) amax = fmaxf(amax, __shfl_xor(amax, o));
        const float inv = amax > 0.f ? 127.0f / amax : 0.f;
        if (lane == 0) hsc[row] = amax * (1.0f / 127.0f);
#pragma unroll
        for (int j = 0; j < 4; ++j) { const int c = 8 * lane + 512 * j; const f4 a = v[j][0], b = v[j][1];
            v2u qv; qv.x = q8x4(a[0] * inv, a[1] * inv, a[2] * inv, a[3] * inv); qv.y = q8x4(b[0] * inv, b[1] * inv, b[2] * inv, b[3] * inv);
            *(v2u*)(HA + (size_t)row * D + c) = qv; }
    }
    unsigned char* ws = A.ws;
    LAS float* scr = (LAS float*)(lds + wave * CV_SCR);
    const int gw = bx * 8 + wave, NGW = G * 8;
    { const float wsc_ = ((const float*)(ws + WQ_WSC))[32]; CvItem c; c.N = NIN; c.inv = 1.0f / wsc_; c.lim = 127.0f * wsc_;
#pragma unroll 1
      for (int it = gw; it < 16 * 290; it += NGW) { const int kb = it / 290, nb = it % 290; f4 va[16];
          c.src = A.in[I_WIN] + (size_t)(128 * kb) * NIN + 32 * nb; c.dst = ws + WS_WIN + (size_t)(win_drow(64 * (nb >> 1)) + 32 * (nb & 1)) * 2048 + 128 * kb;
          CV_LOAD(va, c); CV_FINISH(va, c); } }
#pragma unroll 1
    for (int it = gw; it < IT_OUT; it += NGW) { const int kb = it >> 5, nb = it & 31; tr_item<false>(A.in[I_WOUT], 2048, (bf16*)(ws + WS_WOUT), 4096, 64 * kb, 64 * nb, 64 * nb, scr, lane); }
    __syncthreads();
}

__device__ __forceinline__ void p3_ssdconv(CArgs& A, int tid, int bx, int G) {
    typedef unsigned v3u __attribute__((ext_vector_type(3)));
    const bf16* XBC = (const bf16*)(A.ws + WS_XBC); bf16* XC = (bf16*)(A.ws + WS_XBCC);
    const int c = 6 * tid;
    f2 w0[3], w1[3], w2[3], bb[3];
#pragma unroll
    for (int i = 0; i < 3; ++i) { w0[i] = *(const f2*)(A.in[I_SCW] + c + 2 * i); w1[i] = *(const f2*)(A.in[I_SCW] + DXBC + c + 2 * i); w2[i] = *(const f2*)(A.in[I_SCW] + 2 * DXBC + c + 2 * i); bb[i] = *(const f2*)(A.in[I_SCB] + c + 2 * i); }
    const v3u zero = {0u, 0u, 0u};
#pragma unroll 1
    for (int strip = bx; strip < 768; strip += G) {
        const int r0 = 12 * strip;
        v3u raw[14];
#pragma unroll
        for (int i = 0; i < 14; ++i) { const int r = r0 - 1 + i; raw[i] = (r >= 0 && r < MA) ? *(const v3u*)(XBC + (size_t)r * DXBC + c) : zero; }
#pragma unroll
        for (int i = 0; i < 12; ++i) { const int r = r0 + i;
            int t, L; if (r < M) { t = r & 2047; L = 2048; } else { t = (r - M) & 255; L = 256; }
            const v3u pu = t > 0 ? raw[i] : zero, qu = raw[i + 1], nu = t < L - 1 ? raw[i + 2] : zero;
            v3u ov;
#pragma unroll
            for (int k = 0; k < 3; ++k) {
                const f2 x = w0[k] * (f2){bflo(pu[k]), bfhi(pu[k])} + (w1[k] * (f2){bflo(qu[k]), bfhi(qu[k])} + (w2[k] * (f2){bflo(nu[k]), bfhi(nu[k])} + bb[k]));
                const f2 tt = x * (-1.44269504f);
                const f2 den = (f2){__builtin_amdgcn_exp2f(tt.x), __builtin_amdgcn_exp2f(tt.y)} + 1.0f;
                const f2 o2 = x * (f2){__builtin_amdgcn_rcpf(den.x), __builtin_amdgcn_rcpf(den.y)};
                ov[k] = pk2(o2.x, o2.y); }
            *(v3u*)(XC + (size_t)r * DXBC + c) = ov; }
    }
}

__device__ __forceinline__ void p3_confconv(CArgs& A, LAS unsigned char* lds, int tid, int bx, int G) {
    const bf16* V = (const bf16*)(A.ws + WS_V); bf16* YC = (bf16*)(A.ws + WS_YC);
    LAS f2* tile = (LAS f2*)lds;
    const int cp = tid & 63, q = tid >> 6;
#pragma unroll 1
    for (int cb = bx; cb < 256; cb += G) {
        const int combo = cb >> 4, sub = cb & 15; const bool colconv = combo >= 8; const int cbase = 128 * combo;
        f2 w[31];
#pragma unroll
        for (int k = 0; k < 31; ++k) w[k] = *(const f2*)(A.in[I_CDW] + (size_t)k * 2048 + cbase + 2 * cp);
        const f2 bias = *(const f2*)(A.in[I_CDB] + cbase + 2 * cp);
#define TOK(b_, rr_, pos) ((b_) * 2048 + (colconv ? (((pos) & 31) * 64 + 2 * (rr_) + ((pos) >> 5)) : ((rr_) * 64 + (pos))))
        unsigned pf[8];
        { const int it = sub * 8, b = it >> 5, rr = it & 31;
#pragma unroll
          for (int i = 0; i < 8; ++i) pf[i] = *(const unsigned*)(V + (size_t)TOK(b, rr, q + 8 * i) * 2048 + cbase + 2 * cp); }
#pragma unroll 1
        for (int ii = 0; ii < 8; ++ii) {
            const int it = sub * 8 + ii, b = it >> 5, rr = it & 31;
            __syncthreads();
#pragma unroll
            for (int i = 0; i < 8; ++i) tile[(q + 8 * i) * 64 + cp] = (f2){bflo(pf[i]), bfhi(pf[i])};
            __syncthreads();
            if (ii < 7) { const int it2 = it + 1, b2 = it2 >> 5, rr2 = it2 & 31;
#pragma unroll
                for (int i = 0; i < 8; ++i) pf[i] = *(const unsigned*)(V + (size_t)TOK(b2, rr2, q + 8 * i) * 2048 + cbase + 2 * cp); }
            const int p0 = 8 * q, lo = colconv ? (q >> 2) * 32 : 0, hi = colconv ? lo + 32 : 64;
            f2 o[8];
#pragma unroll
            for (int j = 0; j < 8; ++j) o[j] = bias;
#pragma unroll
            for (int d = 0; d < 38; ++d) {
                const int idx = p0 - 15 + d;
                f2 val = {0.f, 0.f};
                if (idx >= lo && idx < hi) val = tile[idx * 64 + cp];
#pragma unroll
                for (int j = 0; j < 8; ++j) { const int k = d - j; if (k >= 0 && k < 31) { o[j].x += w[k].x * val.x; o[j].y += w[k].y * val.y; } }
            }
#pragma unroll
            for (int j = 0; j < 8; ++j) { const int pos = p0 + j; *(unsigned*)(YC + (size_t)TOK(b, rr, pos) * 2048 + cbase + 2 * cp) = pk2(o[j].x, o[j].y); }
        }
#undef TOK
    }
}
#define MFMA32(a, b, c) __builtin_amdgcn_mfma_f32_32x32x16_bf16((a), (b), (c), 0, 0, 0)
constexpr int SRS = 272;
constexpr int SXP = 192;
constexpr int S_BM = 0, S_CM = 32768, S_X = 67584, S_XH = 92160, S_PB = 116736, S_MT = 134144, S_TAB = 159744;
constexpr int SMP = 80, SMT = 32 * SMP;
static_assert(S_TAB + 1024 <= TAB_OFF, "scan images below the persistent LDS tables");
__device__ __forceinline__ unsigned bm_off(unsigned row, unsigned ch) { return 256u * row + 16u * (ch ^ (((row & 3u) << 2) | ((row >> 2) & 3u))); }
#define TR4(d0, d1, d2, d3, addr, o0, o1, o2, o3) asm volatile("ds_read_b64_tr_b16 %0, %4 offset:%5\n\tds_read_b64_tr_b16 %1, %4 offset:%6\n\tds_read_b64_tr_b16 %2, %4 offset:%7\n\tds_read_b64_tr_b16 %3, %4 offset:%8\n\ts_waitcnt lgkmcnt(0)" \
        : "=&v"(d0), "=&v"(d1), "=&v"(d2), "=&v"(d3) : "v"(addr), "n"(o0), "n"(o1), "n"(o2), "n"(o3) : "memory")
#define TR8(a00, a01, a10, a11, b00, b01, b10, b11, addrA, oA0, oA1, oA2, oA3, addrB0, addrB1, oB0, oB1) asm volatile( \
        "ds_read_b64_tr_b16 %0, %8 offset:%11\n\tds_read_b64_tr_b16 %1, %8 offset:%12\n\tds_read_b64_tr_b16 %2, %8 offset:%13\n\tds_read_b64_tr_b16 %3, %8 offset:%14\n\t" \
        "ds_read_b64_tr_b16 %4, %9 offset:%15\n\tds_read_b64_tr_b16 %5, %10 offset:%15\n\tds_read_b64_tr_b16 %6, %9 offset:%16\n\tds_read_b64_tr_b16 %7, %10 offset:%16\n\ts_waitcnt lgkmcnt(0)" \
        : "=&v"(a00), "=&v"(a01), "=&v"(a10), "=&v"(a11), "=&v"(b00), "=&v"(b01), "=&v"(b10), "=&v"(b11) \
        : "v"(addrA), "v"(addrB0), "v"(addrB1), "n"(oA0), "n"(oA1), "n"(oA2), "n"(oA3), "n"(oB0), "n"(oB1) : "memory")
__device__ __forceinline__ void p4_scan(CArgs& A, LAS unsigned char* lds, int tid, int lane, int wave, int bx, int G) {
    const bf16* XC = (const bf16*)(A.ws + WS_XBCC); const float* DT = (const float*)(A.ws + WS_DT);
    LAS float* sAc = (LAS float*)(lds + S_TAB); LAS float* sDt = sAc + 128;
    asm volatile("" : "+v"(lane), "+v"(tid));
    const int r = lane & 31, hh = lane >> 5, pt = wave & 1, lt = wave >> 1;
    const unsigned ldsb = (unsigned)(size_t)lds;
    const int tq = (lane & 15) >> 2, tp = lane & 3, tblk = (lane >> 4) & 1;
    const unsigned xcol = (unsigned)(32 * pt + 16 * tblk + 4 * tp) * 2u;
    const unsigned xa_natx = ldsb + S_X + (unsigned)(8 * hh + tq) * SXP + xcol;
    const unsigned xa_nat = ldsb + S_XH + (unsigned)(8 * hh + tq) * SXP + xcol;
    const unsigned bt0 = ldsb + S_BM + bm_off(8 * hh + tq, 4 * lt + 2 * tblk + (tp >> 1)) + 8 * (tp & 1);
    const unsigned bt1 = ldsb + S_BM + bm_off(8 * hh + 4 + tq, 4 * lt + 2 * tblk + (tp >> 1)) + 8 * (tp & 1);
    const unsigned bm_m = ((r & 3u) << 2) | ((r >> 2) & 3u);
    const int vcu = (G % 8 == 0) ? (bx % 8) * (G / 8) + bx / 8 : bx;
#pragma unroll 1
    for (int item = vcu; item < 256; item += G) {
        const int b = item >> 6, h = (item >> 1) & 31, dir = item & 1, g = h >> 3;
        const float Aneg = -expf(A.in[dir ? I_ALB : I_ALF][h]), dbias = A.in[dir ? I_DBB : I_DBF][h];
        bf16* Yout = (bf16*)(A.ws + (dir ? WS_YB : WS_YF));
        f16v stt;
#pragma unroll
        for (int i = 0; i < 16; ++i) stt[i] = 0.f;
        for (int i = tid; i < 64 * SRS / 4; i += 512) ((LAS unsigned*)(lds + S_PB))[i] = 0u;
#define ROWST(st_, l) (((st_) < 2 ? M + b * TC : b * T) + (dir ? (((st_) < 2 ? TC : T) - 1 - (128 * ((st_) < 2 ? (st_) : (st_) - 2) + (l))) : (128 * ((st_) < 2 ? (st_) : (st_) - 2) + (l))))
        v4u pfb[4], pfc[4], pfx[2]; float pfd0 = 0.f, pfd1 = 0.f;
#define PREFETCH(st_) do { \
            _Pragma("unroll") for (int i = 0; i < 4; ++i) { const int q = tid + 512 * i, rl = q >> 4, pc = q & 15; const bf16* src = XC + (size_t)ROWST(st_, rl) * DXBC + 2048 + 128 * g + 8 * pc; \
                pfb[i] = *(const v4u*)src; pfc[i] = *(const v4u*)(src + 512); } \
            { const int l = tid & 127, pq = tid >> 7; const bf16* src = XC + (size_t)ROWST(st_, l) * DXBC + 64 * h + 16 * pq; pfx[0] = *(const v4u*)src; pfx[1] = *(const v4u*)(src + 8); } \
            pfd0 = DT[(size_t)ROWST(st_, 2 * lane) * 64 + dir * 32 + h]; pfd1 = DT[(size_t)ROWST(st_, 2 * lane + 1) * 64 + dir * 32 + h]; } while (0)
        PREFETCH(0);
#pragma unroll 1
        for (int st = 0; st < 18; ++st) {
            const bool isctx = st < 2;
#define ROWOF(l) ROWST(st, l)
            __syncthreads();
            if (st > 0) {
                LAS bf16* d = (LAS bf16*)(lds + S_PB + (32 * pt + 4 * hh) * SRS + (32 * lt + r) * 2);
#pragma unroll
                for (int i = 0; i < 16; i += 2) { const unsigned u = pk2(stt[i], stt[i + 1]); const int p0 = (i & 3) + 8 * (i >> 2);
                    d[p0 * (SRS / 2)] = (bf16)(u & 0xffffu); d[(p0 + 1) * (SRS / 2)] = (bf16)(u >> 16); }
            }
            float sc0, sc1;
            { const int l0 = 2 * lane;
              const float x0 = pfd0 + dbias, x1 = pfd1 + dbias;
              const float d0 = x0 > 20.f ? x0 : __logf(1.0f + __expf(x0)), d1 = x1 > 20.f ? x1 : __logf(1.0f + __expf(x1));
              const float a0 = d0 * Aneg, a1 = d1 * Aneg;
              float incl = a0 + a1;
#pragma unroll
              for (int o = 1; o < 64; o <<= 1) { const float t = __shfl_up(incl, o); if (lane >= o) incl += t; }
              const float c1 = incl, c0 = incl - a1, tot = __shfl(incl, 63);
              sc0 = d0 * __expf(tot - c0); sc1 = d1 * __expf(tot - c1);
              if (wave == 0) { sAc[l0] = c0; sAc[l0 + 1] = c1; sDt[l0] = d0; sDt[l0 + 1] = d1; } }
#pragma unroll
            for (int i = 0; i < 4; ++i) { const int q = tid + 512 * i, rl = q >> 4, pc = q & 15;
                *(LAS v4u*)(lds + S_BM + bm_off(rl, pc)) = pfb[i]; *(LAS v4u*)(lds + S_CM + rl * SRS + pc * 16) = pfc[i]; }
            { const int l = tid & 127, pq = tid >> 7, src = (wave & 1) * 32 + (lane >> 1);
              const float e0 = __shfl(sc0, src), e1 = __shfl(sc1, src), sl = (lane & 1) ? e1 : e0;
#pragma unroll
              for (int i = 0; i < 2; ++i) { const int off = l * SXP + (16 * pq + 8 * i) * 2; float f[8]; unpack8(pfx[i], f);
                  *(LAS v4u*)(lds + S_X + off) = pfx[i];
#pragma unroll
                  for (int e = 0; e < 8; ++e) f[e] *= sl;
                  *(LAS v4u*)(lds + S_XH + off) = pack8(f); } }
            if (st == 2 * ((bx >> 3) & 7) + 2) conv_simple(A, IT_GU - IT_P4 + ((bx >> 3) & 7) * (IT_P4 / 8), IT_GU - IT_P4 + (((bx >> 3) & 7) + 1) * (IT_P4 / 8), (((bx >> 6) << 3) + (bx & 7)) * 8 + wave, 256, lane);
            __syncthreads();
            if (st < 17) PREFETCH(st + 1);
            if (!isctx) {
#pragma unroll 1
                for (int tix = wave; tix < 10; tix += 8) {
                    const int lt_a = tix >= 6 ? 3 : (tix >= 3 ? 2 : (tix >= 1 ? 1 : 0)), st_a = tix - ((lt_a * (lt_a + 1)) >> 1);
                    h8 cfa[8], afa[8];
                    const LAS unsigned char* brow = lds + S_BM + 256 * (32 * st_a + r);
#pragma unroll
                    for (int k = 0; k < 8; ++k) { cfa[k] = *(const LAS h8*)(lds + S_CM + (32 * lt_a + r) * SRS + (16 * k + 8 * hh) * 2); afa[k] = *(const LAS h8*)(brow + 16 * ((unsigned)(2 * k + hh) ^ bm_m)); }
                    f4 tac[4], tdt[4];
#pragma unroll
                    for (int g4 = 0; g4 < 4; ++g4) { tac[g4] = *(const LAS f4*)(sAc + 32 * st_a + 8 * g4 + 4 * hh); tdt[g4] = *(const LAS f4*)(sDt + 32 * st_a + 8 * g4 + 4 * hh); }
                    const float acl_a = sAc[32 * lt_a + r];
                    LDS_WAIT();
                    f16v gt;
#pragma unroll
                    for (int i = 0; i < 16; ++i) gt[i] = 0.f;
#pragma unroll
                    for (int k = 0; k < 8; ++k) gt = MFMA32(afa[k], cfa[k], gt);
                    const bool diag = (st_a == lt_a);
#pragma unroll
                    for (int i = 0; i < 16; ++i) { const int sl = (i & 3) + 8 * (i >> 2) + 4 * hh;
                        const float f = __expf(acl_a - tac[i >> 2][i & 3]) * tdt[i >> 2][i & 3];
                        gt[i] = (diag && sl > r) ? 0.f : gt[i] * f; }
                    LAS unsigned char* mt = lds + S_MT + tix * SMT + r * SMP + 8 * hh;
#pragma unroll
                    for (int g4 = 0; g4 < 4; ++g4) { v2u o; o.x = pk2(gt[4 * g4], gt[4 * g4 + 1]); o.y = pk2(gt[4 * g4 + 2], gt[4 * g4 + 3]); *(LAS v2u*)(mt + 16 * g4) = o; }
                }
            }
            __syncthreads();
            if (!isctx) {
                f16v y;
#pragma unroll
                for (int i = 0; i < 16; ++i) y[i] = 0.f;
                { h8 cf[8], af[8];
#pragma unroll
                  for (int k = 0; k < 8; ++k) { cf[k] = *(const LAS h8*)(lds + S_CM + (32 * lt + r) * SRS + (16 * k + 8 * hh) * 2); af[k] = *(const LAS h8*)(lds + S_PB + (32 * pt + r) * SRS + (16 * k + 8 * hh) * 2); }
                  LDS_WAIT();
#pragma unroll
                  for (int k = 0; k < 8; ++k) y = MFMA32(af[k], cf[k], y); }
                const float el = __expf(sAc[32 * lt + r]);
#pragma unroll
                for (int i = 0; i < 16; ++i) y[i] *= el;
#pragma unroll 1
                for (int s_t = 0; s_t <= lt; ++s_t) {
                    const LAS unsigned char* mt = lds + S_MT + (((lt * (lt + 1)) >> 1) + s_t) * SMT + r * SMP + 16 * hh;
                    const h8 b0 = *(const LAS h8*)mt, b1 = *(const LAS h8*)(mt + 32);
                    v2u xa0, xa1, xa2, xa3;
                    { const unsigned xad = xa_natx + (unsigned)(32 * s_t) * SXP; TR4(xa0, xa1, xa2, xa3, xad, 0, 4 * SXP, 16 * SXP, 20 * SXP); }
                    v4u pa; pa.x = xa0.x; pa.y = xa0.y; pa.z = xa1.x; pa.w = xa1.y;
                    y = MFMA32(__builtin_bit_cast(h8, pa), b0, y);
                    pa.x = xa2.x; pa.y = xa2.y; pa.z = xa3.x; pa.w = xa3.y;
                    y = MFMA32(__builtin_bit_cast(h8, pa), b1, y);
                }
                bf16* yrow = Yout + (size_t)ROWOF(32 * lt + r) * 2048 + 64 * h + 32 * pt + 4 * hh;
#pragma unroll
                for (int gq = 0; gq < 4; ++gq) { v2u o; o.x = pk2(y[4 * gq], y[4 * gq + 1]); o.y = pk2(y[4 * gq + 2], y[4 * gq + 3]); *(v2u*)(yrow + 8 * gq) = o; }
            }
            if (st < 17) {
                const float dA = __expf(sAc[127]);
#pragma unroll
                for (int i = 0; i < 16; ++i) stt[i] *= dA;
#pragma unroll
                for (int kh = 0; kh < 4; ++kh) {
                    v2u a00, a01, a10, a11, b00, b01, b10, b11;
                    TR8(a00, a01, a10, a11, b00, b01, b10, b11, xa_nat, (32 * kh) * SXP, (32 * kh + 4) * SXP, (32 * kh + 16) * SXP, (32 * kh + 20) * SXP, bt0, bt1, 8192 * kh, 8192 * kh + 4096);
                    v4u fa, fb;
                    fa.x = a00.x; fa.y = a00.y; fa.z = a01.x; fa.w = a01.y; fb.x = b00.x; fb.y = b00.y; fb.z = b01.x; fb.w = b01.y;
                    stt = MFMA32(__builtin_bit_cast(h8, fa), __builtin_bit_cast(h8, fb), stt);
                    fa.x = a10.x; fa.y = a10.y; fa.z = a11.x; fa.w = a11.y; fb.x = b10.x; fb.y = b10.y; fb.z = b11.x; fb.w = b11.y;
                    stt = MFMA32(__builtin_bit_cast(h8, fa), __builtin_bit_cast(h8, fb), stt);
                }
            }
#undef ROWOF
        }
#undef PREFETCH
#undef ROWST
        __syncthreads();
    }
}

__device__ __forceinline__ void p5_mix(CArgs& A, int lane, int wave, int bx, int G) {
    const bf16* YF = (const bf16*)(A.ws + WS_YF); const bf16* YB = (const bf16*)(A.ws + WS_YB); const bf16* XC = (const bf16*)(A.ws + WS_XBCC);
    const bf16* Z = (const bf16*)(A.ws + WS_Z); const bf16* YC = (const bf16*)(A.ws + WS_YC); bf16* MIX = (bf16*)(A.ws + WS_MIX);
#pragma unroll 1
    for (int row = bx * 8 + wave; row < M; row += G * 8) {
#pragma unroll
        for (int j = 0; j < 4; ++j) { const int c = 8 * lane + 512 * j; const float dsk = A.in[I_DSKIP][(lane >> 3) + 8 * j];
            float yf[8], yb[8], xs[8], z[8], y[8];
            unpack8(*(const v4u*)(YF + (size_t)row * 2048 + c), yf); unpack8(*(const v4u*)(YB + (size_t)row * 2048 + c), yb);
            unpack8(*(const v4u*)(XC + (size_t)row * DXBC + c), xs); unpack8(*(const v4u*)(Z + (size_t)row * 2048 + c), z);
            float ss = 0.f;
#pragma unroll
            for (int i = 0; i < 8; ++i) { y[i] = (yf[i] + yb[i] + dsk * xs[i]) * siluf(z[i]); ss += y[i] * y[i]; }
            const float rstd = 1.0f / sqrtf(wave_sum(ss) * (1.0f / 512.0f) + EPS);
            const f4 g0 = *(const f4*)(A.in[I_SNG] + c), g1 = *(const f4*)(A.in[I_SNG] + c + 4);
#pragma unroll
            for (int i = 0; i < 4; ++i) { y[i] = y[i] * rstd * g0[i]; y[4 + i] = y[4 + i] * rstd * g1[i]; }
            *(v4u*)(MIX + (size_t)row * 4096 + c) = pack8(y); }
        float v[4][8]; float s = 0.f;
#pragma unroll
        for (int j = 0; j < 4; ++j) { unpack8(*(const v4u*)(YC + (size_t)row * 2048 + 8 * lane + 512 * j), v[j]);
#pragma unroll
            for (int i = 0; i < 8; ++i) s += v[j][i]; }
        const float mu = wave_sum(s) * (1.0f / 2048.0f); float q = 0.f;
#pragma unroll
        for (int j = 0; j < 4; ++j)
#pragma unroll
            for (int i = 0; i < 8; ++i) { v[j][i] -= mu; q += v[j][i] * v[j][i]; }
        const float rs = 1.0f / sqrtf(wave_sum(q) * (1.0f / 2048.0f) + EPS);
#pragma unroll
        for (int j = 0; j < 4; ++j) { const int c = 8 * lane + 512 * j; float o[8];
#pragma unroll
            for (int qq = 0; qq < 2; ++qq) { const f4 g = *(const f4*)(A.in[I_CLG] + c + 4 * qq), bb = *(const f4*)(A.in[I_CLB] + c + 4 * qq);
#pragma unroll
                for (int i = 0; i < 4; ++i) o[4 * qq + i] = siluf(v[j][4 * qq + i] * rs * g[i] + bb[i]); }
            *(v4u*)(MIX + (size_t)row * 4096 + 2048 + c) = pack8(o); }
    }
}
__device__ __forceinline__ void p7_router(CArgs& A, LAS unsigned char* lds, int tid, int lane, int wave, int bx, int G) {
    const float* X1 = (const float*)(A.ws + WS_X1); const float* mod = (const float*)(A.ws + WS_MOD);
    LAS unsigned char* h2l = lds + 20480; constexpr int H2P = 4112;
    const bf16* WH = (const bf16*)(A.ws + WS_WRT); const bf16* WL = WH + 65536;
    int* top_idx = (int*)(A.ws + WS_ROUTE + RT_IDX); float* top_w = (float*)(A.ws + WS_ROUTE + RT_W); int* bcnt = (int*)(A.ws + WS_ROUTE + RT_BCNT);
    LAS float* part = (LAS float*)lds;
    LAS int* cnt = (LAS int*)(lds + 16384);
    const float* gffn = A.in[I_GFFN]; unsigned char* H2Q = A.ws + WS_H2Q; float* HSC = (float*)(A.ws + WQ_HSC); float* HN = (float*)(A.ws + WQ_HN);
#pragma unroll 1
    for (int tg = bx; tg < 256; tg += G) {
        const int tok0 = 32 * tg;
        if (tid < 32) cnt[tid] = 0;
#pragma unroll 1
        for (int rp = 0; rp < 2; ++rp) { f4 v[2][4][2];
#pragma unroll
          for (int rr = 0; rr < 2; ++rr) { const float* src = X1 + (size_t)(tok0 + 4 * wave + 2 * rp + rr) * D;
#pragma unroll
              for (int j = 0; j < 4; ++j) { const int c = 8 * lane + 512 * j; v[rr][j][0] = *(const f4*)(src + c); v[rr][j][1] = *(const f4*)(src + c + 4); } }
          const float* sh = mod + (size_t)(tok0 >> 11) * NMOD + 6144; const float* sc = sh + 2048;
#pragma unroll
          for (int rr = 0; rr < 2; ++rr) { const int row = tok0 + 4 * wave + 2 * rp + rr; float ss = 0.f;
#pragma unroll
              for (int j = 0; j < 4; ++j)
#pragma unroll
                  for (int q = 0; q < 2; ++q)
#pragma unroll
                      for (int i = 0; i < 4; ++i) ss += v[rr][j][q][i] * v[rr][j][q][i];
              const float rstd = 1.0f / sqrtf(wave_sum(ss) * (1.0f / D) + EPS);
              float amax = 0.f, hn2 = 0.f;
#pragma unroll
              for (int j = 0; j < 4; ++j) { const int c = 8 * lane + 512 * j;
#pragma unroll
                  for (int q = 0; q < 2; ++q) { const f4 g = *(const f4*)(gffn + c + 4 * q), s = *(const f4*)(sc + c + 4 * q), h = *(const f4*)(sh + c + 4 * q);
#pragma unroll
                      for (int i = 0; i < 4; ++i) { const float o = v[rr][j][q][i] * rstd * g[i] * (1.0f + s[i]) + h[i]; v[rr][j][q][i] = o; amax = fmaxf(amax, fabsf(o)); hn2 += o * o; } } }
              hn2 = wave_sum(hn2); if (lane == 0) HN[row] = sqrtf(hn2);
#pragma unroll
              for (int o = 1; o < 64; o <<= 1) amax = fmaxf(amax, __shfl_xor(amax, o));
              const float inv = amax > 0.f ? 127.0f / amax : 0.f;
              if (lane == 0) HSC[row] = amax * (1.0f / 127.0f);
#pragma unroll
              for (int j = 0; j < 4; ++j) { const int c = 8 * lane + 512 * j; const f4 a = v[rr][j][0], b = v[rr][j][1];
                  v4u w; w.x = pk2(a[0], a[1]); w.y = pk2(a[2], a[3]); w.z = pk2(b[0], b[1]); w.w = pk2(b[2], b[3]);
                  *(LAS v4u*)(h2l + (4 * wave + 2 * rp + rr) * H2P + 2 * c) = w;
                  v2u qv; qv.x = q8x4(a[0] * inv, a[1] * inv, a[2] * inv, a[3] * inv); qv.y = q8x4(b[0] * inv, b[1] * inv, b[2] * inv, b[3] * inv);
                  *(v2u*)(H2Q + (size_t)row * D + c) = qv; } } }
        __syncthreads();
        LAS float* part8 = (LAS float*)(lds + 32768);
        { const int kp = wave, i16 = lane & 15, kq = lane >> 4;
          pg8::f32x4 acc00 = {0.f, 0.f, 0.f, 0.f}, acc01 = acc00, acc10 = acc00, acc11 = acc00;
          const LAS unsigned char* ap = h2l + i16 * H2P + 2 * (256 * kp + 8 * kq);
          const bf16* bh0 = WH + (size_t)i16 * 2048 + 256 * kp + 8 * kq; const bf16* bl0 = WL + (size_t)i16 * 2048 + 256 * kp + 8 * kq;
          h8 wh0[8], wl0[8], wh1[8], wl1[8];
#pragma unroll
          for (int s = 0; s < 8; ++s) { wh0[s] = *(const h8*)(bh0 + 32 * s); wl0[s] = *(const h8*)(bl0 + 32 * s); wh1[s] = *(const h8*)(bh0 + 16 * 2048 + 32 * s); wl1[s] = *(const h8*)(bl0 + 16 * 2048 + 32 * s); }
#pragma unroll
          for (int s = 0; s < 8; ++s) { const h8 a0 = *(const LAS h8*)(ap + 64 * s), a1 = *(const LAS h8*)(ap + 16 * H2P + 64 * s);
              const h8 h0 = wh0[s], l0 = wl0[s], h1 = wh1[s], l1 = wl1[s];
              acc00 = __builtin_amdgcn_mfma_f32_16x16x32_bf16(a0, h0, acc00, 0, 0, 0); acc00 = __builtin_amdgcn_mfma_f32_16x16x32_bf16(a0, l0, acc00, 0, 0, 0);
              acc01 = __builtin_amdgcn_mfma_f32_16x16x32_bf16(a0, h1, acc01, 0, 0, 0); acc01 = __builtin_amdgcn_mfma_f32_16x16x32_bf16(a0, l1, acc01, 0, 0, 0);
              acc10 = __builtin_amdgcn_mfma_f32_16x16x32_bf16(a1, h0, acc10, 0, 0, 0); acc10 = __builtin_amdgcn_mfma_f32_16x16x32_bf16(a1, l0, acc10, 0, 0, 0);
              acc11 = __builtin_amdgcn_mfma_f32_16x16x32_bf16(a1, h1, acc11, 0, 0, 0); acc11 = __builtin_amdgcn_mfma_f32_16x16x32_bf16(a1, l1, acc11, 0, 0, 0); }
          __syncthreads();
          LAS float* p0 = part8 + ((0 * 8 + kp) * 16 + 4 * kq) * 32 + i16; LAS float* p1 = part8 + ((1 * 8 + kp) * 16 + 4 * kq) * 32 + i16;
#pragma unroll
          for (int i = 0; i < 4; ++i) { p0[i * 32] = acc00[i]; p0[i * 32 + 16] = acc01[i]; p1[i * 32] = acc10[i]; p1[i * 32 + 16] = acc11[i]; } }
        __syncthreads();
        if (tid < 32) { const int tile = tid >> 4, tl = tid & 15; float v[32];
#pragma unroll
            for (int e = 0; e < 32; ++e) { float s = A.in[I_BR][e];
#pragma unroll
                for (int kp = 0; kp < 8; ++kp) s += part8[((tile * 8 + kp) * 16 + tl) * 32 + e];
                v[e] = s; }
            unsigned taken = 0u; float tv[4]; int ti[4];
#pragma unroll
            for (int k = 0; k < 4; ++k) { float best = -3.0e38f; int bi = 0;
#pragma unroll
                for (int e = 0; e < 32; ++e) { const bool ok = !((taken >> e) & 1u) && (v[e] > best); best = ok ? v[e] : best; bi = ok ? e : bi; }
                taken |= 1u << bi; tv[k] = best; ti[k] = bi; }
            const float e1 = expf(tv[1] - tv[0]), e2 = expf(tv[2] - tv[0]), e3 = expf(tv[3] - tv[0]); const float inv = 1.0f / (1.0f + e1 + e2 + e3);
            const int tok = tok0 + tid;
            *(int4*)(top_idx + 4 * tok) = make_int4(ti[0], ti[1], ti[2], ti[3]);
            *(f4*)(top_w + 4 * tok) = (f4){inv, e1 * inv, e2 * inv, e3 * inv};
#pragma unroll
            for (int k = 0; k < 4; ++k) atomicAdd((int*)(cnt + ti[k]), 1); }
        __syncthreads();
        { int t2 = tid; asm volatile("" : "+v"(t2)); if (t2 < 32) bcnt[tg * 32 + t2] = cnt[t2]; }
        __syncthreads();
    }
}

__device__ __forceinline__ void p8_route(CArgs& A, LAS unsigned char* lds, int tid, int lane, int wave, int bx, int G) {
    const unsigned char* H2Q = A.ws + WS_H2Q; unsigned char* HS = A.ws + WS_HS; const float* HSC = (const float*)(A.ws + WQ_HSC); float* slot_sa = (float*)(A.ws + WQ_SSA); float* slot_asc = (float*)(A.ws + WS_ROUTE + RT_ASC); const float* HN = (const float*)(A.ws + WQ_HN); const float* WSC = (const float*)(A.ws + WQ_WSC);
    const int* top_idx = (const int*)(A.ws + WS_ROUTE + RT_IDX); const float* top_w = (const float*)(A.ws + WS_ROUTE + RT_W);
    int* tok_slot = (int*)(A.ws + WS_ROUTE + RT_SLOT); const int* bcnt = (const int*)(A.ws + WS_ROUTE + RT_BCNT); int* cumT_g = (int*)(A.ws + WS_ROUTE + RT_CUMT);
    float* slot_w = (float*)(A.ws + WS_ROUTE + RT_SW);
    LAS int* tab = (LAS int*)lds;
    LAS int* tot = (LAS int*)(lds + 32768);
    LAS int* off = tot + 32;
    LAS int* se = off + 40;
    LAS int* spos = se + 128;
    LAS int* base = spos + 128;
    LAS int* psum = base + 32;
    { int t2 = tid; asm volatile("" : "+v"(t2)); for (int i = t2; i < 8192; i += 512) tab[i] = bcnt[i]; }
    __syncthreads();
    { const int e = tid & 31, part = tid >> 5; int s = 0;
#pragma unroll
      for (int i = 0; i < 16; ++i) s += tab[(part * 16 + i) * 32 + e];
      psum[part * 32 + e] = s; }
    __syncthreads();
    if (tid < 32) { int s = 0;
#pragma unroll
        for (int p = 0; p < 16; ++p) s += psum[p * 32 + tid];
        tot[tid] = s; }
    __syncthreads();
    if (tid == 0) { int o = 0, hsum = 0, fsum = 0, nodd = 0;
        for (int e = 0; e < 32; ++e) { off[e] = o; const int m = (tot[e] + 127) >> 7;
            if (bx == 0) { cumT_g[e] = fsum; cumT_g[33 + e] = hsum; if (m & 1) cumT_g[67 + nodd] = e; }
            o += m << 7; hsum += m; fsum += m >> 1; nodd += m & 1; }
        off[32] = o; if (bx == 0) { cumT_g[32] = fsum; cumT_g[65] = hsum; cumT_g[66] = nodd; } }
    __syncthreads();
    for (int e = bx; e < 32; e += G) { const int r0 = off[e] + tot[e], r1 = off[e + 1]; const v4u zero = {0u, 0u, 0u, 0u};
        for (int row = r0 + wave; row < r1; row += 8) { v4u* d = (v4u*)(HS + (size_t)row * D);
#pragma unroll
            for (int j = 0; j < 2; ++j) d[lane + 64 * j] = zero;
            if (lane == 0) { slot_w[row] = 0.f; slot_sa[row] = 0.f; slot_asc[row] = 0.f; } } }
#pragma unroll 1
    for (int tg = bx; tg < 256; tg += G) {
        const int tok0 = 32 * tg;
        __syncthreads();
        if (tid < 32) { int s = 0; const int pfull = tg >> 4; for (int p = 0; p < pfull; ++p) s += psum[p * 32 + tid]; for (int b2 = pfull * 16; b2 < tg; ++b2) s += tab[b2 * 32 + tid]; base[tid] = s; }
        if (tid >= 64 && tid < 192) se[tid - 64] = top_idx[4 * tok0 + (tid - 64)];
        __syncthreads();
        if (tid < 128) { const int e = se[tid]; int rank = 0; for (int s2 = 0; s2 < tid; ++s2) rank += (se[s2] == e) ? 1 : 0;
            const int pos = off[e] + base[e] + rank; spos[tid] = pos; tok_slot[4 * tok0 + tid] = pos; slot_w[pos] = top_w[4 * tok0 + tid]; slot_sa[pos] = HSC[tok0 + (tid >> 2)];
            const float sg = HN[tok0 + (tid >> 2)] * WSC[e] * (127.0f / WQ_CLIP); slot_asc[pos] = 1.25f * (3.6f * sg + 4.6f * sg * sg) * (1.0f / 127.0f); }
        __syncthreads();
        { v4u rowv[4][2];
#pragma unroll
          for (int t = 0; t < 4; ++t) { const v4u* src = (const v4u*)(H2Q + (size_t)(tok0 + wave * 4 + t) * D); rowv[t][0] = src[lane]; rowv[t][1] = src[lane + 64]; }
#pragma unroll
          for (int t = 0; t < 4; ++t)
#pragma unroll
              for (int k = 0; k < 4; ++k) { v4u* d = (v4u*)(HS + (size_t)spos[wave * 16 + 4 * t + k] * D); d[lane] = rowv[t][0]; d[lane + 64] = rowv[t][1]; } }
    }
}

__device__ __forceinline__ void p11_final(CArgs& A, int lane, int wave, int bx, int G) {
    const float* X1 = (const float*)(A.ws + WS_X1); const float* mod = (const float*)(A.ws + WS_MOD); const bf16* YS = (const bf16*)(A.ws + WS_YS);
    const int* tok_slot = (const int*)(A.ws + WS_ROUTE + RT_SLOT); const float* gfin = A.in[I_GFIN];
#pragma unroll 1
    for (int row = bx * 8 + wave; row < M; row += G * 8) {
        const float* gf = mod + (size_t)(row >> 11) * NMOD + 10240; const int4 sl = *(const int4*)(tok_slot + 4 * row);
        const bf16* y0 = YS + (size_t)sl.x * D; const bf16* y1 = YS + (size_t)sl.y * D; const bf16* y2 = YS + (size_t)sl.z * D; const bf16* y3 = YS + (size_t)sl.w * D;
        float x2[4][8]; float ss = 0.f;
#pragma unroll
        for (int j = 0; j < 4; ++j) { const int c = 8 * lane + 512 * j; float a[8], b[8], cc[8], d[8];
            unpack8(*(const v4u*)(y0 + c), a); unpack8(*(const v4u*)(y1 + c), b); unpack8(*(const v4u*)(y2 + c), cc); unpack8(*(const v4u*)(y3 + c), d);
#pragma unroll
            for (int q = 0; q < 2; ++q) { const f4 xv = *(const f4*)(X1 + (size_t)row * D + c + 4 * q), g = *(const f4*)(gf + c + 4 * q);
#pragma unroll
                for (int i = 0; i < 4; ++i) { const float m = (a[4 * q + i] + b[4 * q + i]) + (cc[4 * q + i] + d[4 * q + i]); const float v = xv[i] + g[i] * m; x2[j][4 * q + i] = v; ss += v * v; } } }
        const float rstd = 1.0f / sqrtf(wave_sum(ss) * (1.0f / D) + EPS);
#pragma unroll
        for (int j = 0; j < 4; ++j) { const int c = 8 * lane + 512 * j;
#pragma unroll
            for (int q = 0; q < 2; ++q) { const f4 g = *(const f4*)(gfin + c + 4 * q); f4 o;
#pragma unroll
                for (int i = 0; i < 4; ++i) o[i] = x2[j][4 * q + i] * rstd * g[i];
                *(f4*)(A.out + (size_t)row * D + c + 4 * q) = o; } }
    }
}
constexpr int CW_CVQ = 64;
#ifndef CV_SPLIT
#define CV_SPLIT ((IT_GU - IT_P4) / 2)
#endif
#ifndef CV_SPLIT_D
#define CV_SPLIT_D (IT_GU + IT_D / 2)
#endif
__global__ void __launch_bounds__(512, 2) hybrid_fwd(Args A) {
    extern __shared__ __attribute__((aligned(16))) unsigned char lds_raw[];
    LAS unsigned char* lds = (LAS unsigned char*)lds_raw;
    const int tid = threadIdx.x, lane = tid & 63, wave = __builtin_amdgcn_readfirstlane(tid >> 6), bx = blockIdx.x, G = gridDim.x;
    for (int u = tid; u < (LDS_BYTES - TAB_OFF) / 4; u += 512) ((LAS unsigned*)(lds + TAB_OFF))[u] = 0u;
    __syncthreads();
    CArgs* kap = (CArgs*)__builtin_amdgcn_kernarg_segment_ptr();
#define KA() (*({ CArgs* p_ = kap; asm volatile("" : "+s"(p_)); p_; }))
    XcdBarrier bar = xcd_barrier_post((unsigned*)(A.ws + WS_CTL) + CW_BAR + A.li * XCD_BAR_WORDS, (volatile LAS unsigned*)(lds + TAB_OFF + 1024));
    const int lo = A.ph_lo, hi = A.ph_hi;
#define IN(k) (lo <= (k) && (k) < hi)
#ifndef PROBE_MASK
#define PROBE_MASK 0
#endif
#define REP(k) for (int rep_ = 0; rep_ < (((PROBE_MASK) >> (k)) & 1) + 1; ++rep_)
#define SEAM(k) do { if (IN(k) && IN((k) + 1)) xcd_barrier(bar); } while (0)

    if (IN(0)) REP(0) { p0_prologue(KA(), lds, tid, lane, wave, bx, G); } SEAM(0);
    if (IN(1)) REP(1) { p1_norm(KA(), lds, lane, wave, bx, G); } SEAM(1);
    if (IN(2)) REP(2) {
        unsigned char* ws = KA().ws;
        pg8::Gemm g{(const pg8::bf16_t*)(ws + WS_HA), (const pg8::bf16_t*)(ws + WS_WIN), MA, NINP, D / 2};
        InProjOrder S; S.init(G, bx);
        EpiInProj E{(bf16*)(ws + WS_Z), (bf16*)(ws + WS_XBC), (bf16*)(ws + WS_V), (float*)(ws + WS_DT), (const float*)(ws + WQ_HASC), (const float*)(ws + WQ_WSC)};
        const int half = (bx >> 3) & 1, rank = (((bx >> 4) << 3) + (bx & 7)) * 8 + wave, nrank = (G >> 1) * 8;
        if (half) { conv_static(KA(), 0, CV_SPLIT, rank, nrank, lds, lane, wave); __syncthreads(); }
        pg8::gemm_phase<EpiInProj, InProjOrder, PG8_ALIGN, PG8_SP2, true>(lds, g, S, E);
        if (!half) conv_static(KA(), CV_SPLIT, IT_GU - IT_P4, rank, nrank, lds, lane, wave);
        __syncthreads();
    } SEAM(2);
    if (IN(3)) REP(3) { p3_confconv(KA(), lds, tid, bx, G); p3_ssdconv(KA(), tid, bx, G); } SEAM(3);
    if (IN(4)) REP(4) { p4_scan(KA(), lds, tid, lane, wave, bx, G); } SEAM(4);
    if (IN(5)) REP(5) { p5_mix(KA(), lane, wave, bx, G); } SEAM(5);
    if (IN(6)) REP(6) {
        CArgs& B = KA(); unsigned char* ws = B.ws;
        pg8::Gemm g{(const pg8::bf16_t*)(ws + WS_MIX), (const pg8::bf16_t*)(ws + WS_WOUT), M, D, 4096};
        pg8::StaticOrder S; S.init(M, D, G, bx);
        EpiOutProj E{B.in[I_X], (const float*)(ws + WS_MOD), (float*)(ws + WS_X1)};
        pg8::gemm_phase<EpiOutProj, pg8::StaticOrder, PG8_ALIGN, PG8_SP2>(lds, g, S, E);
    } SEAM(6);
    if (IN(7)) REP(7) { p7_router(KA(), lds, tid, lane, wave, bx, G); } SEAM(7);
    if (IN(8)) REP(8) { p8_route(KA(), lds, tid, lane, wave, bx, G); } SEAM(8);
    if (IN(9) || IN(10)) {
        unsigned char* ws = KA().ws;
        LAS int* cumT = (LAS int*)(lds + TAB_OFF);
        { int t2 = tid; asm volatile("" : "+v"(t2)); if (t2 < 99) cumT[t2] = ((const int*)(ws + WS_ROUTE + RT_CUMT))[t2]; }
        __syncthreads();
    }
    if (IN(9)) REP(9) {
        CArgs& B = KA(); unsigned char* ws = B.ws;
        pg8::Gemm g{(const pg8::bf16_t*)(ws + WS_HS), (const pg8::bf16_t*)(ws + WS_WGU), MPMAX, NE * 4096, D / 2};
        MoeOrder S{(const LAS int*)(lds + TAB_OFF), 16, G, bx};
        EpiGateUp E{B.in[I_BGU], (const float*)(ws + WQ_SSA), (const float*)(ws + WQ_WSC), (const float*)(ws + WS_ROUTE + RT_ASC), ws + WS_ACT};
        const int grp = (bx >> 3) & 7, rank = (((bx >> 6) << 3) + (bx & 7)) * 8 + wave, it_lo = IT_GU + grp * (IT_D / 8);
#pragma unroll 1
        for (int seg = 0; seg < 2; ++seg) {
            S.i0 = seg ? grp : 0; S.i1 = seg ? (1 << 20) : grp;
            pg8::gemm_phase<EpiGateUp, MoeOrder, PG8_ALIGN, PG8_SP2, true, true>(lds, g, S, E);
            if (seg == 0) conv_static(B, it_lo, it_lo + IT_D / 8, rank, 256, lds, lane, wave);
        }
    } SEAM(9);
    if (IN(10)) REP(10) {
        CArgs& B = KA(); unsigned char* ws = B.ws;
        pg8::Gemm g{(const pg8::bf16_t*)(ws + WS_ACT), (const pg8::bf16_t*)(ws + WS_WD), MPMAX, NE * 2048, DFF / 2};
        MoeOrder S{(const LAS int*)(lds + TAB_OFF), 8, G, bx};
        EpiDown E{B.in[I_BD], (const float*)(ws + WS_ROUTE + RT_SW), (const float*)(ws + WS_ROUTE + RT_ASC), (const float*)(ws + WQ_WSC), (bf16*)(ws + WS_YS)};
        pg8::gemm_phase<EpiDown, MoeOrder, PG8_ALIGN, PG8_SP2, true, true>(lds, g, S, E);
    } SEAM(10);
    if (IN(11)) REP(11) { p11_final(KA(), lane, wave, bx, G); }
#undef IN
#undef SEAM
}

extern "C" void kernel_launch(void* const* d_in, const int* in_sizes, int n_in, void* d_out, int out_size, void* d_ws, size_t ws_size, hipStream_t stream) {
    static int grid = 0;
    if (grid == 0) {
        if (n_in != 29 || out_size != M * D || ws_size < WS_END) { fprintf(stderr, "kernel_launch: unexpected problem (n_in %d, out %d, ws %zu)\n", n_in, out_size, ws_size); grid = -1; return; }
        if (hipFuncSetAttribute((const void*)hybrid_fwd, hipFuncAttributeMaxDynamicSharedMemorySize, LDS_BYTES) != hipSuccess) { fprintf(stderr, "kernel_launch: hipFuncSetAttribute failed\n"); grid = -1; return; }
        int per_cu = 0;
        if (hipOccupancyMaxActiveBlocksPerMultiprocessor(&per_cu, (const void*)hybrid_fwd, 512, LDS_BYTES) != hipSuccess || per_cu < 1) fprintf(stderr, "kernel_launch: occupancy query reports %d\n", per_cu);
        (void)hipGetLastError();
        grid = 256;
    }
    if (grid < 0) return;
    (void)in_sizes;
    if (hipMemsetAsync((char*)d_ws + WS_CTL, 0, CTL_ZERO_BYTES, stream) != hipSuccess) { fprintf(stderr, "kernel_launch: memset failed\n"); return; }
    Args a{};
    for (int i = 0; i < 29; ++i) a.in[i] = (const float*)d_in[i];
    a.out = (float*)d_out; a.ws = (unsigned char*)d_ws; a.pad = 0;
#if MK_LAUNCHES == 1
    a.ph_lo = 0; a.ph_hi = NPHASE; a.li = 0;
    hipLaunchKernelGGL(hybrid_fwd, dim3(grid), dim3(512), LDS_BYTES, stream, a);
#else
    for (int li = 0; li < NPHASE; ++li) { a.ph_lo = li; a.ph_hi = li + 1; a.li = li; hipLaunchKernelGGL(hybrid_fwd, dim3(grid), dim3(512), LDS_BYTES, stream, a); }
#endif
    const hipError_t le = hipPeekAtLastError();
    if (le != hipSuccess) fprintf(stderr, "kernel_launch: launch failed: %s\n", hipGetErrorName(le));
}
```

```cpp
#include <hip/hip_runtime.h>
#include <cstdio>
#include <cstdint>

namespace pg8 {
#define PG8_LAS __attribute__((address_space(3)))
typedef unsigned short bf16_t;
typedef short bf16x8 __attribute__((ext_vector_type(8)));
typedef float f32x4 __attribute__((ext_vector_type(4)));
typedef unsigned u32x4 __attribute__((ext_vector_type(4)));
typedef int i32x4 __attribute__((ext_vector_type(4)));
constexpr int BM = 256, BK = 64, HALF = 128, HTB = HALF * BK * 2  , STAGE_BYTES = 8 * HTB, NXCD = 8, WGM = 8;

__host__ __device__ __forceinline__ int lds_byte(int r, int c) { const int st = (r >> 4) * 2 + (c >> 5), rr = r & 15, cc = c & 31, ob = rr * 64 + cc * 2; return st * 1024 + (ob ^ (((ob >> 9) & 1) << 5)); }
__host__ __device__ __forceinline__ void stage_rc(int b, int& R, int& C) { const int st = b / 1024, sb = b % 1024, swz = sb ^ (((sb >> 9) & 1) << 5); R = (st >> 1) * 16 + swz / 64; C = (st & 1) * 32 + (swz % 64) / 2; }
__host__ __device__ __forceinline__ int perm32(int rho) { const int n = rho >> 4, i = rho & 15; return 8 * (i >> 2) + 4 * n + (i & 3); }

struct Unit { int pm, pn; };
struct Gemm { const bf16_t* A; const bf16_t* Bt; int M, N, K; };

struct StaticOrder {
    int nM, nN, nwg, G, c;
    __host__ __device__ void init(int M, int N, int G_, int c_) { nM = M / BM; nN = N / BM; nwg = nM * nN; G = G_; c = c_; }
    __host__ __device__ bool next(int i, Unit& u) const {
        const long L = (long)i * G + c; if (L >= nwg) return false;
        int wgid = (int)L; { const int q = nwg / NXCD, r = nwg % NXCD, xcd = wgid % NXCD, off = wgid / NXCD; wgid = (xcd < r ? xcd * (q + 1) : r * (q + 1) + (xcd - r) * q) + off; }
        const int nig = WGM * nN, gid = wgid / nig, fm = gid * WGM, gsz = (nM - fm) < WGM ? (nM - fm) : WGM;
        u.pm = fm + ((wgid % nig) % gsz); u.pn = (wgid % nig) / gsz; return true;
    }
    __device__ __forceinline__ void a_ready(const Unit&) const {}
    __device__ __forceinline__ void done(const Unit&) const {}
};
__device__ __forceinline__ unsigned cvt_pk_bf16(float lo, float hi) { unsigned r; asm volatile("v_cvt_pk_bf16_f32 %0, %1, %2" : "=v"(r) : "v"(lo), "v"(hi)); return r; }
typedef float f32x2 __attribute__((ext_vector_type(2)));
template <class Epi, class Sched, bool ALIGN_EPI = false, bool SP2 = false, bool I8 = false, bool HALFM = false>
__device__ __forceinline__ void gemm_phase(PG8_LAS unsigned char* lds, const Gemm g, const Sched& S, const Epi& E) {
    int tid_ = threadIdx.x; asm volatile("" : "+v"(tid_));
    const int tid = tid_, wid = __builtin_amdgcn_readfirstlane(tid >> 6), lane = tid & 63, wr = wid >> 2, wc = wid & 3, fr = lane & 15, fq = lane >> 4;
    const int K = g.K, nt = K / BK;
    unsigned voffA[2], voffB[2];
#pragma unroll
    for (int i = 0; i < 2; ++i) { int R, C; stage_rc(tid * 16 + i * 8192, R, C); const int Rb = Epi::PERM ? ((R & ~31) + perm32(R & 31)) : R;
        voffA[i] = (unsigned)(R * K + C) * 2u; voffB[i] = (unsigned)(Rb * K + C) * 2u; }
    const size_t kstep = (size_t)(BK * 2);
    const size_t hstep = (size_t)HALF * K * 2;
    const size_t tstep = 2 * hstep;
    const unsigned ldsw = (unsigned)wid * 1024u;
    const int aoff = lds_byte(wr * 64 + fr, fq * 8), boff = lds_byte(wc * 32 + fr, fq * 8);
#define PG8_SA(b, h) (((b) * 2 + (h)) * HTB)
#define PG8_SB(b, h) ((4 + (b) * 2 + (h)) * HTB)
#define PG8_STAGE(bufoff, gbase, voff) do { _Pragma("unroll") for (int _i = 0; _i < 2; ++_i) \
        __builtin_amdgcn_global_load_lds((const unsigned*)((const char*)(gbase) + (voff)[_i]), (PG8_LAS unsigned*)(lds + (bufoff) + ldsw + _i * 8192), 16, 0, 0); } while (0)
#define PG8_LDA(dst, b, h) do { _Pragma("unroll") for (int m = 0; m < 4; ++m) _Pragma("unroll") for (int k = 0; k < 2; ++k) dst[m][k] = *(const PG8_LAS bf16x8*)(lds + PG8_SA(b, h) + aoff + m * 2048 + k * 1024); } while (0)
#define PG8_LDB(dst, b, h) do { _Pragma("unroll") for (int n = 0; n < 2; ++n) _Pragma("unroll") for (int k = 0; k < 2; ++k) dst[n][k] = *(const PG8_LAS bf16x8*)(lds + PG8_SB(b, h) + boff + n * 2048 + k * 1024); } while (0)
#define PG8_MMA(ai, bj, At, Bt) do { __builtin_amdgcn_s_setprio(1); _Pragma("unroll") for (int m = 0; m < 4; ++m) _Pragma("unroll") for (int n = 0; n < 2; ++n) _Pragma("unroll") for (int k = 0; k < 2; ++k) { \
        if constexpr (I8) acc[ai][bj][m][n] = __builtin_bit_cast(f32x4, __builtin_amdgcn_mfma_i32_16x16x64_i8(__builtin_bit_cast(i32x4, Bt[n][k]), __builtin_bit_cast(i32x4, At[m][k]), __builtin_bit_cast(i32x4, acc[ai][bj][m][n]), 0, 0, 0)); \
        else acc[ai][bj][m][n] = __builtin_amdgcn_mfma_f32_16x16x32_bf16(Bt[n][k], At[m][k], acc[ai][bj][m][n], 0, 0, 0); } __builtin_amdgcn_s_setprio(0); } while (0)
#define PG8_WAIT_V(n) asm volatile("s_waitcnt vmcnt(" #n ")" ::: "memory")
#define PG8_WAIT_L(n) asm volatile("s_waitcnt lgkmcnt(" #n ")" ::: "memory")
#define PG8_BAR __builtin_amdgcn_s_barrier()
#define PG8_SCHED __builtin_amdgcn_sched_barrier(0)
    Unit cur, nxt; int ui = 0;
    if (!S.next(0, cur)) return;
    f32x4 acc[2][2][4][2];
#pragma unroll
    for (int a = 0; a < 2; ++a)
#pragma unroll
        for (int b = 0; b < 2; ++b)
#pragma unroll
            for (int m = 0; m < 4; ++m)
#pragma unroll
                for (int n = 0; n < 2; ++n) acc[a][b][m][n] = (f32x4){0.f, 0.f, 0.f, 0.f};
    bf16x8 At[4][2], B0[2][2], B1[2][2];
    const char* cA = (const char*)g.A + (HALFM ? (size_t)(cur.pm & 0xffff) * hstep : (size_t)cur.pm * tstep); const char* cB = (const char*)g.Bt + (size_t)cur.pn * tstep;
    S.a_ready(cur);
    if constexpr (SP2) {
        PG8_STAGE(PG8_SB(0, 0), cB, voffB); PG8_STAGE(PG8_SB(0, 1), cB + hstep, voffB); PG8_STAGE(PG8_SA(0, 0), cA, voffA); PG8_STAGE(PG8_SA(0, 1), cA + hstep, voffA);
        if (wr == 1) PG8_BAR;
        PG8_WAIT_V(2); PG8_BAR;
        PG8_STAGE(PG8_SB(1, 0), cB + kstep, voffB); PG8_STAGE(PG8_SA(1, 0), cA + kstep, voffA); PG8_STAGE(PG8_SB(1, 1), cB + hstep + kstep, voffB);
        PG8_WAIT_V(6); PG8_BAR;
    } else {
        PG8_STAGE(PG8_SB(0, 0), cB, voffB); PG8_STAGE(PG8_SA(0, 0), cA, voffA); PG8_STAGE(PG8_SB(0, 1), cB + hstep, voffB); PG8_STAGE(PG8_SA(0, 1), cA + hstep, voffA);
        if (wr == 1) PG8_BAR;
        PG8_WAIT_V(4); PG8_BAR;
        PG8_STAGE(PG8_SB(1, 0), cB + kstep, voffB); PG8_STAGE(PG8_SA(1, 0), cA + kstep, voffA); PG8_STAGE(PG8_SB(1, 1), cB + hstep + kstep, voffB);
        PG8_WAIT_V(6); PG8_BAR;
    }
    for (;;) {
        const bool has_next = S.next(ui + 1, nxt);
        const char* nA = has_next ? (const char*)g.A + (HALFM ? (size_t)(nxt.pm & 0xffff) * hstep : (size_t)nxt.pm * tstep) : cA;
          const bool full = !HALFM || ((cur.pm >> 17) & 1); const char* nB = has_next ? (const char*)g.Bt + (size_t)nxt.pn * tstep : cB;
        for (int t = 0; t < nt; t += 2) {
            const bool last = (t == nt - 2);
            const char* a1 = cA + (size_t)(t + 1) * kstep;
            const char* a2 = last ? nA : cA + (size_t)(t + 2) * kstep; const char* b2 = last ? nB : cB + (size_t)(t + 2) * kstep;
            const char* a3 = a2 + kstep; const char* b3 = b2 + kstep;
            if (last && has_next) S.a_ready(nxt);
            if constexpr (SP2) {
            PG8_LDB(B0, 0, 0); PG8_LDB(B1, 0, 1); PG8_SCHED; PG8_LDA(At, 0, 0); PG8_STAGE(PG8_SA(1, 1), a1 + hstep, voffA);
            PG8_WAIT_V(8); PG8_WAIT_L(0); PG8_BAR; PG8_MMA(0, 0, At, B0); PG8_MMA(0, 1, At, B1); PG8_BAR; PG8_SCHED;
            PG8_LDA(At, 0, 1); PG8_STAGE(PG8_SB(0, 0), b2, voffB); PG8_STAGE(PG8_SB(0, 1), b2 + hstep, voffB); PG8_STAGE(PG8_SA(0, 0), a2, voffA);
            PG8_WAIT_V(8); PG8_WAIT_L(0); PG8_BAR; if (full) { PG8_MMA(1, 0, At, B0); PG8_MMA(1, 1, At, B1); } PG8_BAR; PG8_SCHED;
            PG8_LDB(B0, 1, 0); PG8_LDB(B1, 1, 1); PG8_SCHED; PG8_LDA(At, 1, 0); PG8_STAGE(PG8_SA(0, 1), a2 + hstep, voffA);
            PG8_WAIT_V(8); PG8_WAIT_L(0); PG8_BAR; PG8_MMA(0, 0, At, B0); PG8_MMA(0, 1, At, B1); PG8_BAR; PG8_SCHED;
            PG8_LDA(At, 1, 1); PG8_STAGE(PG8_SB(1, 0), b3, voffB); PG8_STAGE(PG8_SB(1, 1), b3 + hstep, voffB); PG8_STAGE(PG8_SA(1, 0), a3, voffA);
            PG8_WAIT_V(8); PG8_WAIT_L(0); PG8_BAR; if (full) { PG8_MMA(1, 0, At, B0); PG8_MMA(1, 1, At, B1); } PG8_BAR; PG8_SCHED;
            } else {
            PG8_LDB(B0, 0, 0); PG8_SCHED; PG8_LDA(At, 0, 0); PG8_STAGE(PG8_SA(1, 1), a1 + hstep, voffA);
            PG8_WAIT_L(8); PG8_BAR; PG8_WAIT_L(0); PG8_MMA(0, 0, At, B0); PG8_BAR; PG8_SCHED;
            PG8_LDB(B1, 0, 1); PG8_STAGE(PG8_SB(0, 0), b2, voffB);
            PG8_BAR; PG8_WAIT_L(0); PG8_MMA(0, 1, At, B1); PG8_BAR;
            PG8_LDA(At, 0, 1); PG8_STAGE(PG8_SA(0, 0), a2, voffA);
            PG8_BAR; PG8_WAIT_L(0); PG8_MMA(1, 0, At, B0); PG8_BAR; PG8_SCHED;
            PG8_STAGE(PG8_SB(0, 1), b2 + hstep, voffB);
            PG8_WAIT_V(6); PG8_BAR; PG8_MMA(1, 1, At, B1); PG8_BAR;
            PG8_LDB(B0, 1, 0); PG8_SCHED; PG8_LDA(At, 1, 0); PG8_STAGE(PG8_SA(0, 1), a2 + hstep, voffA);
            PG8_WAIT_L(8); PG8_BAR; PG8_WAIT_L(0); PG8_MMA(0, 0, At, B0); PG8_BAR; PG8_SCHED;
            PG8_LDB(B1, 1, 1); PG8_STAGE(PG8_SB(1, 0), b3, voffB);
            PG8_BAR; PG8_WAIT_L(0); PG8_MMA(0, 1, At, B1); PG8_BAR;
            PG8_LDA(At, 1, 1); PG8_STAGE(PG8_SA(1, 0), a3, voffA);
            PG8_BAR; PG8_WAIT_L(0); PG8_MMA(1, 0, At, B0); PG8_BAR; PG8_SCHED;
            PG8_STAGE(PG8_SB(1, 1), b3 + hstep, voffB);
            PG8_WAIT_V(6); PG8_BAR; PG8_MMA(1, 1, At, B1); PG8_BAR;
            }
        }
        if constexpr (ALIGN_EPI) { if (wr == 0) PG8_BAR; }
        if constexpr (!Epi::AFTER_DRAIN) { E(acc, cur, wr, wc, fr, fq); S.done(cur); }
        if (!has_next) break;
#pragma unroll
        for (int a = 0; a < 2; ++a)
#pragma unroll
            for (int b = 0; b < 2; ++b)
#pragma unroll
                for (int m = 0; m < 4; ++m)
#pragma unroll
                    for (int n = 0; n < 2; ++n) acc[a][b][m][n] = (f32x4){0.f, 0.f, 0.f, 0.f};
        cur = nxt; cA = nA; cB = nB; ++ui;
        if constexpr (ALIGN_EPI) { if (wr == 1) PG8_BAR; }
    }
    PG8_WAIT_V(0);
    if constexpr (!ALIGN_EPI) { if (wr == 0) PG8_BAR; }
    PG8_BAR;
    if constexpr (Epi::AFTER_DRAIN) { E.fused(acc, cur, wr, wc, fr, fq, lds, wid, lane); S.done(cur); }
#undef PG8_SA
#undef PG8_SB
#undef PG8_STAGE
#undef PG8_LDA
#undef PG8_LDB
#undef PG8_MMA
#undef PG8_WAIT_V
#undef PG8_WAIT_L
#undef PG8_BAR
#undef PG8_SCHED
}
}
#ifndef PG8_SP2
#define PG8_SP2 true
#endif
#ifndef PG8_ALIGN
#define PG8_ALIGN true
#endif
#ifndef MK_LAUNCHES
#define MK_LAUNCHES 1
#endif
constexpr int NPHASE = 12;

constexpr int NB = 4, T = 2048, D = 2048, M = NB * T;
constexpr int TC = 256, MC = NB * TC, MA = M + MC;
constexpr int NIN = 9280, NINP = 9472;
constexpr int DXBC = 3072, NH = 32, HD = 64, DST = 128;
constexpr int NE = 32, DFF = 2048, NMOD = 12288;
constexpr int MPMAX = 40960;
constexpr float EPS = 1e-6f;

constexpr size_t MiB = 1u << 20;
constexpr size_t WS_CTL = 0, CTL_ZERO_BYTES = 1 * MiB;
constexpr size_t WS_MOD = 1 * MiB;
constexpr size_t WS_WRT = 2 * MiB;
constexpr size_t WS_ROUTE = 3 * MiB;
constexpr size_t RT_IDX = 0, RT_W = 131072, RT_SLOT = 262144, RT_BCNT = 393216, RT_CUMT = 425984, RT_SW = 430080, RT_ASC = 786432;
constexpr size_t WQ_HN = WS_WRT + 589824;
constexpr size_t WS_DT = 4 * MiB;
constexpr size_t WS_WIN = 8 * MiB;
constexpr size_t WS_WOUT = 46 * MiB;
constexpr size_t WS_WGU = 64 * MiB;
constexpr size_t WS_WD = 576 * MiB;
constexpr size_t WS_HA = 832 * MiB;
constexpr size_t WS_Z = 868 * MiB;
constexpr size_t WS_XBC = 900 * MiB;
constexpr size_t WS_V = 954 * MiB;
constexpr size_t WS_XBCC = 986 * MiB;
constexpr size_t WS_YF = 1040 * MiB, WS_YB = 1072 * MiB;
constexpr size_t WS_YC = 1104 * MiB;
constexpr size_t WS_MIX = 1136 * MiB;
constexpr size_t WS_X1 = 1200 * MiB;
constexpr size_t WS_H2 = 1264 * MiB;
constexpr size_t WS_HS = 1296 * MiB;
constexpr size_t WS_ACT = 1456 * MiB;
constexpr size_t WS_YS = 1616 * MiB;
constexpr size_t WS_H2Q = 1776 * MiB;
constexpr size_t WS_END = 1792 * MiB;
constexpr size_t WQ_HSC = WS_WRT + 262144, WQ_WSC = WS_WRT + 327680, WQ_SSA = WS_WRT + 393216;
constexpr size_t WQ_HASC = WS_WRT + 720896;
constexpr size_t WQ_MSC = WS_WRT + 655360;
constexpr float WQ_CLIP = 3.8f;
constexpr int CW_BAR = 4096;
static_assert(RT_SW + (size_t)MPMAX * 4 <= RT_ASC && RT_ASC + (size_t)MPMAX * 4 <= MiB, "route region");

constexpr int TAB_OFF = 160768;
constexpr int LDS_BYTES = 163840;

#define GAS __attribute__((address_space(1)))
#define LAS __attribute__((address_space(3)))
typedef unsigned short bf16;
typedef unsigned v4u __attribute__((ext_vector_type(4)));
typedef unsigned v2u __attribute__((ext_vector_type(2)));
typedef float f4 __attribute__((ext_vector_type(4)));
typedef float f2 __attribute__((ext_vector_type(2)));
typedef float f16v __attribute__((ext_vector_type(16)));
typedef short h8 __attribute__((ext_vector_type(8)));
typedef short h4 __attribute__((ext_vector_type(4)));
typedef __bf16 bfv2 __attribute__((ext_vector_type(2)));
#define LDS_WAIT() asm volatile("s_waitcnt lgkmcnt(0)" ::: "memory")
#define VM_WAIT() asm volatile("s_waitcnt vmcnt(0)" ::: "memory")
__device__ __forceinline__ unsigned pk2(float lo, float hi) { f2 v = {lo, hi}; return __builtin_bit_cast(unsigned, __builtin_convertvector(v, bfv2)); }
__device__ __forceinline__ float bflo(unsigned u) { return __uint_as_float(u << 16); }
__device__ __forceinline__ float bfhi(unsigned u) { return __uint_as_float(u & 0xffff0000u); }
__device__ __forceinline__ float bf1(bf16 u) { return __uint_as_float(((unsigned)u) << 16); }
__device__ __forceinline__ float wave_sum(float v) {
#pragma unroll
    for (int o = 1; o < 64; o <<= 1) v += __shfl_xor(v, o);
    return v;
}
__device__ __forceinline__ float sigm(float x) { return __builtin_amdgcn_rcpf(1.0f + __expf(-x)); }
__device__ __forceinline__ float siluf(float x) { return x * __builtin_amdgcn_rcpf(1.0f + __expf(-x)); }
__device__ __forceinline__ void unpack8(const v4u u, float (&f)[8]) { f[0] = bflo(u.x); f[1] = bfhi(u.x); f[2] = bflo(u.y); f[3] = bfhi(u.y); f[4] = bflo(u.z); f[5] = bfhi(u.z); f[6] = bflo(u.w); f[7] = bfhi(u.w); }
__device__ __forceinline__ v4u pack8(const float (&f)[8]) { v4u o; o.x = pk2(f[0], f[1]); o.y = pk2(f[2], f[3]); o.z = pk2(f[4], f[5]); o.w = pk2(f[6], f[7]); return o; }
__device__ __forceinline__ unsigned q8x4(float a, float b, float c, float d) {
    const unsigned ua = __float_as_uint(__builtin_amdgcn_fmed3f(a, -127.f, 127.f) + 12582912.f), ub = __float_as_uint(__builtin_amdgcn_fmed3f(b, -127.f, 127.f) + 12582912.f),
                   uc = __float_as_uint(__builtin_amdgcn_fmed3f(c, -127.f, 127.f) + 12582912.f), ud = __float_as_uint(__builtin_amdgcn_fmed3f(d, -127.f, 127.f) + 12582912.f);
    return (ua & 0xffu) | ((ub & 0xffu) << 8) | ((uc & 0xffu) << 16) | (ud << 24);
}
__device__ __forceinline__ unsigned pack4b(float a, float b, float c, float d) {
    return __builtin_amdgcn_perm(__builtin_amdgcn_perm(__float_as_uint(d), __float_as_uint(c), 0x0c0c0400u), __builtin_amdgcn_perm(__float_as_uint(b), __float_as_uint(a), 0x0c0c0400u), 0x05040100u);
}
#ifndef MIXF_S
#define MIXF_S 1.0f
#endif
#ifndef MIXF_C
#define MIXF_C 2.0f
#endif
#define XB_TMO      128
#define XB_XCNT(j)  (256  + 64 * (j))
#define XB_XSUB(j)  (1280 + 64 * (j))
#define XB_XGEN(j)  (2304 + 64 * (j))
#define XB_TOP      3328
#define XB_TOPGEN   3392
#define XCD_BAR_WORDS 3456
#define XB_SPIN_CAP (1u << 18)

__device__ __forceinline__ unsigned xb_ld(unsigned* p)              { return __hip_atomic_load(p, __ATOMIC_RELAXED, __HIP_MEMORY_SCOPE_AGENT); }
__device__ __forceinline__ unsigned xb_add(unsigned* p, unsigned v) { return __hip_atomic_fetch_add(p, v, __ATOMIC_RELAXED, __HIP_MEMORY_SCOPE_AGENT); }
__device__ __forceinline__ unsigned xb_xcc_id() { return (unsigned)__builtin_amdgcn_s_getreg((3 << 11) | 20) & 0xFu; }
#define XB_SPIN(cond, bar) do { unsigned _sp = 0; while (cond) { __builtin_amdgcn_s_sleep(1); \
    if ((++_sp & 255u) == 0u) { if (xb_ld(&(bar)[XB_TMO])) break; if (_sp > XB_SPIN_CAP) { atomicAdd(&(bar)[XB_TMO], 1u); break; } } } } while (0)

struct XcdBarrier {
    unsigned* bar; unsigned x;
    volatile LAS unsigned* st;
};

__device__ __forceinline__ XcdBarrier xcd_barrier_post(unsigned* bar, volatile LAS unsigned* st) {
    XcdBarrier b; b.bar = bar; b.x = xb_xcc_id(); b.st = st;
    if (threadIdx.x == 0) (void)xb_add(&bar[XB_XCNT(b.x)], 1u);
    return b;
}
__device__ __forceinline__ void xcd_barrier_complete(unsigned* bar, unsigned x, unsigned& nloc, unsigned& nx) {
    const unsigned G = gridDim.x * gridDim.y * gridDim.z;
    unsigned sum, cnt, mine, sp = 0u;
    for (;;) {
        sum = 0u; cnt = 0u; mine = 0u;
#pragma unroll
        for (unsigned j = 0; j < 16; ++j) { const unsigned c = xb_ld(&bar[XB_XCNT(j)]); sum += c; cnt += (c > 0u) ? 1u : 0u; mine = (j == x) ? c : mine; }
        if (sum == G) break;
        __builtin_amdgcn_s_sleep(1);
        if ((++sp & 255u) == 0u) { if (xb_ld(&bar[XB_TMO])) break; if (sp > XB_SPIN_CAP) { atomicAdd(&bar[XB_TMO], 1u); break; } }
    }
    nloc = mine > 0u ? mine : 1u; nx = cnt > 0u ? cnt : 1u;
}

__device__ __forceinline__ void xcd_barrier(const XcdBarrier& b) {
    asm volatile("s_waitcnt vmcnt(0)" ::: "memory");
    __syncthreads();
    if (threadIdx.x == 0) {
        unsigned* bar = b.bar;
        __builtin_amdgcn_s_waitcnt(0);
        unsigned nloc = b.st[0], nx = b.st[1];
        if (nloc == 0u) { xcd_barrier_complete(bar, b.x, nloc, nx); b.st[0] = nloc; b.st[1] = nx; }
        const unsigned old = xb_add(&bar[XB_XSUB(b.x)], 1u);
        const unsigned gen = old / nloc;
        if (old + 1u == (gen + 1u) * nloc) {
            __builtin_amdgcn_fence(__ATOMIC_RELEASE, "agent");
            asm volatile("s_waitcnt vmcnt(0)" ::: "memory");
            const unsigned og = xb_add(&bar[XB_TOP], 1u);
            const unsigned tg = og / nx;
            if (og + 1u == (tg + 1u) * nx) xb_add(&bar[XB_TOPGEN], 1u);
            else XB_SPIN(xb_ld(&bar[XB_TOPGEN]) == tg, bar);
            __builtin_amdgcn_fence(__ATOMIC_ACQUIRE, "agent");
            xb_add(&bar[XB_XGEN(b.x)], 1u);
            asm volatile("s_waitcnt vmcnt(0)" ::: "memory");
        } else {
            XB_SPIN(xb_ld(&bar[XB_XGEN(b.x)]) == gen, bar);
            __builtin_amdgcn_fence(__ATOMIC_ACQUIRE, "agent");
            asm volatile("s_waitcnt vmcnt(0)" ::: "memory");
        }
    }
    __syncthreads();
}
struct Args { const float* in[29]; float* out; unsigned char* ws; int ph_lo, ph_hi; int li, pad; };
typedef const __attribute__((address_space(4))) Args CArgs;
enum { I_X = 0, I_C, I_CTX, I_CCTX, I_WMOD, I_BMOD, I_GMIX, I_GFFN, I_WIN, I_SCW, I_SCB, I_ALF, I_DBF, I_ALB, I_DBB, I_DSKIP, I_SNG,
       I_CDW, I_CDB, I_CLG, I_CLB, I_WOUT, I_WR, I_BR, I_WGU, I_BGU, I_WD, I_BD, I_GFIN };

struct InProjOrder {
    pg8::StaticOrder so; int G, c, i0, i1;
    __device__ __forceinline__ void init(int G_, int c_) { so.init(M, NINP, G_, c_); G = G_; c = c_; i0 = 0; i1 = 1 << 20; }
    __device__ __forceinline__ bool next(int ii, pg8::Unit& u) const {
        const int i = ii + i0; if (i >= i1) return false;
        const int L = i * G + c;
        if (L < 1184) return so.next(i, u);
        const int r = L - 1184; if (r >= 52) return false;
        const int q = r >> 2; u.pm = 32 + (r & 3); u.pn = q < 12 ? 8 + q : 36; return true;
    }
    __device__ __forceinline__ void a_ready(const pg8::Unit&) const {}
    __device__ __forceinline__ void done(const pg8::Unit&) const {}
};
struct EpiInProj {
    static constexpr bool PERM = true, AFTER_DRAIN = false;
    bf16* Z; bf16* XBC; bf16* V; float* DT; const float* hsc; const float* wsc;
    __device__ __forceinline__ void operator()(const pg8::f32x4 (&acc)[2][2][4][2], const pg8::Unit& u, int wr, int wc, int fr, int fq) const {
        const int row0 = u.pm * 256 + wr * 64 + fr, pn = u.pn; const float ws = wsc[32];
#define IPV4(ai, bj, m, n) (__builtin_convertvector(__builtin_bit_cast(pg8::i32x4, acc[ai][bj][m][n]), pg8::f32x4) * sc)
        if (pn < 20) {
            bf16* base; int ldc, colt;
            if (pn < 8) { base = Z; ldc = 2048; colt = pn * 256; } else { base = XBC; ldc = DXBC; colt = (pn - 8) * 256; }
            const int col0 = colt + wc * 32 + 8 * fq;
#pragma unroll
            for (int ai = 0; ai < 2; ++ai)
#pragma unroll
                for (int m = 0; m < 4; ++m) { const int row = row0 + ai * 128 + m * 16; const float sc = hsc[row] * ws; bf16* rowp = base + (size_t)row * ldc + col0;
#pragma unroll
                    for (int bj = 0; bj < 2; ++bj) { const pg8::f32x4 v0 = IPV4(ai, bj, m, 0), v1 = IPV4(ai, bj, m, 1);
                        v4u w; w.x = pk2(v0[0], v0[1]); w.y = pk2(v0[2], v0[3]); w.z = pk2(v1[0], v1[1]); w.w = pk2(v1[2], v1[3]);
                        *(v4u*)(rowp + bj * 128) = w; } }
        } else if (pn < 36) {
            const int col0 = (pn - 20) * 128 + wc * 32 + 8 * fq;
#pragma unroll
            for (int ai = 0; ai < 2; ++ai)
#pragma unroll
                for (int m = 0; m < 4; ++m) { const int row = row0 + ai * 128 + m * 16; const float sc = hsc[row] * ws; bf16* rowp = V + (size_t)row * 2048 + col0;
                    float o[8];
#pragma unroll
                    for (int n = 0; n < 2; ++n) { const pg8::f32x4 av = IPV4(ai, 0, m, n), tv = IPV4(ai, 1, m, n) * (-1.44269504f);
                        const pg8::f32x4 den = (pg8::f32x4){__builtin_amdgcn_exp2f(tv[0]), __builtin_amdgcn_exp2f(tv[1]), __builtin_amdgcn_exp2f(tv[2]), __builtin_amdgcn_exp2f(tv[3])} + 1.0f;
                        const pg8::f32x4 ov = av * (pg8::f32x4){__builtin_amdgcn_rcpf(den[0]), __builtin_amdgcn_rcpf(den[1]), __builtin_amdgcn_rcpf(den[2]), __builtin_amdgcn_rcpf(den[3])};
#pragma unroll
                        for (int i = 0; i < 4; ++i) o[4 * n + i] = ov[i]; }
                    *(v4u*)rowp = pack8(o); }
        } else {
            if (wc < 2) {
#pragma unroll
                for (int ai = 0; ai < 2; ++ai)
#pragma unroll
                    for (int m = 0; m < 4; ++m) { const int row = row0 + ai * 128 + m * 16; const float sc = hsc[row] * ws; float* rowp = DT + (size_t)row * 64 + wc * 32 + 8 * fq;
                        *(pg8::f32x4*)rowp = IPV4(ai, 0, m, 0); *(pg8::f32x4*)(rowp + 4) = IPV4(ai, 0, m, 1); }
            }
        }
#undef IPV4
    }
};
struct EpiOutProj {
    static constexpr bool PERM = true, AFTER_DRAIN = false;
    const float* x; const float* mod; bf16* X1; const float* msc; const float* wsc;
    __device__ __forceinline__ void operator()(const pg8::f32x4 (&acc)[2][2][4][2], const pg8::Unit& u, int wr, int wc, int fr, int fq) const {
        const int row0 = u.pm * 256 + wr * 64 + fr, col0 = u.pn * 256 + wc * 32 + 8 * fq;
        const float* gm = mod + (size_t)(u.pm >> 3) * NMOD + 4096 + col0; const float ws = wsc[33];
        pg8::f32x4 gv[2][2];
#pragma unroll
        for (int bj = 0; bj < 2; ++bj)
#pragma unroll
            for (int n = 0; n < 2; ++n) gv[bj][n] = *(const pg8::f32x4*)(gm + bj * 128 + 4 * n) * ws;
#pragma unroll
        for (int ai = 0; ai < 2; ++ai)
#pragma unroll
            for (int m = 0; m < 4; ++m) { const int row = row0 + ai * 128 + m * 16; const float sc = msc[row]; const size_t off = (size_t)row * 2048 + col0;
#pragma unroll
                for (int bj = 0; bj < 2; ++bj) {
                    const pg8::f32x4 x0 = *(const pg8::f32x4*)(x + off + bj * 128), x1 = *(const pg8::f32x4*)(x + off + bj * 128 + 4);
                    const pg8::f32x4 v0 = x0 + gv[bj][0] * (__builtin_convertvector(__builtin_bit_cast(pg8::i32x4, acc[ai][bj][m][0]), pg8::f32x4) * sc);
                    const pg8::f32x4 v1 = x1 + gv[bj][1] * (__builtin_convertvector(__builtin_bit_cast(pg8::i32x4, acc[ai][bj][m][1]), pg8::f32x4) * sc);
                    v4u w; w.x = pk2(v0[0], v0[1]); w.y = pk2(v0[2], v0[3]); w.z = pk2(v1[0], v1[1]); w.w = pk2(v1[2], v1[3]);
                    *(v4u*)(X1 + off + bj * 128) = w; } }
    }
};
struct MoeOrder {
    const LAS int* tab; int nN, G, c; int i0 = 0, i1 = 1 << 20;
    __device__ __forceinline__ bool next(int i, pg8::Unit& u) const {
        const int NF = tab[32] * nN, NH = tab[66] * nN, nwg = NF + NH, L = (i + i0) * G + c;
        if (i + i0 >= i1 || L >= nwg) return false;
        const int q = nwg / 8, r = nwg % 8, xcd = L % 8, off = L / 8;
        const int qbase = (xcd < r ? xcd * (q + 1) : r * (q + 1) + (xcd - r) * q), qx = q + (xcd < r ? 1 : 0);
        const int hbase = (NH * xcd) / 8, nhx = (NH * (xcd + 1)) / 8 - hbase, nfx = qx - nhx;
        const int ln = (int)__builtin_amdgcn_mbcnt_hi(~0u, __builtin_amdgcn_mbcnt_lo(~0u, 0u)), cj = tab[ln < 32 ? ln : 32], hj = tab[33 + (ln < 32 ? ln : 32)];
        int e, pm, pnl;
        if (off < nfx) {
            const int F = qbase - hbase + off;
            e = __builtin_popcountll(__ballot(ln < 32 && F >= cj * nN)) - 1;
            const int f0 = __shfl(cj, e), fe = __shfl(cj, e + 1) - f0, v = F - f0 * nN;
            pm = (__shfl(hj, e) + 2 * (v % fe)) | (3 << 16); pnl = v / fe;
        } else {
            const int Hh = hbase + (off - nfx), k = Hh / nN;
            e = tab[67 + k]; pnl = Hh % nN;
            pm = (__shfl(hj, e + 1) - 1) | (1 << 16);
        }
        u.pm = __builtin_amdgcn_readfirstlane(pm); u.pn = __builtin_amdgcn_readfirstlane(e * nN + pnl); return true;
    }
    __device__ __forceinline__ void a_ready(const pg8::Unit&) const {}
    __device__ __forceinline__ void done(const pg8::Unit&) const {}
};
struct EpiGateUp {
    static constexpr bool PERM = true, AFTER_DRAIN = false;
    const float* bgu; const float* ssa; const float* wsc; const float* asc; unsigned char* ACT;
    __device__ __forceinline__ void operator()(const pg8::f32x4 (&acc)[2][2][4][2], const pg8::Unit& u, int wr, int wc, int fr, int fq) const {
        const int e = u.pn >> 4, j = u.pn & 15, row0 = (u.pm & 0xffff) * 128 + wr * 64 + fr, col0 = j * 128 + wc * 32 + 8 * fq; const bool full = (u.pm >> 17) & 1;
        const float* bp = bgu + (size_t)e * 4096 + col0; const float ws = wsc[e];
        const pg8::f32x4 bg0 = *(const pg8::f32x4*)bp, bg1 = *(const pg8::f32x4*)(bp + 4), bl0 = *(const pg8::f32x4*)(bp + 2048), bl1 = *(const pg8::f32x4*)(bp + 2052);
#pragma unroll
        for (int ai = 0; ai < 2; ++ai) if (ai == 0 || full)
#pragma unroll
            for (int m = 0; m < 4; ++m) { const int row = row0 + ai * 128 + m * 16; const float sc = ssa[row] * ws; const float as = asc[row], ainv = as > 0.f ? 1.0f / as : 0.f; unsigned char* rowp = ACT + (size_t)row * 2048 + col0;
                float o[8];
#pragma unroll
                for (int n = 0; n < 2; ++n) { const pg8::i32x4 ig = __builtin_bit_cast(pg8::i32x4, acc[ai][0][m][n]), il = __builtin_bit_cast(pg8::i32x4, acc[ai][1][m][n]);
                    const pg8::f32x4 bgv = n ? bg1 : bg0, blv = n ? bl1 : bl0;
#pragma unroll
                    for (int h = 0; h < 2; ++h) {
                        f2 g = (f2){(float)ig[2 * h], (float)ig[2 * h + 1]} * sc + (f2){bgv[2 * h], bgv[2 * h + 1]};
                        f2 l = (f2){(float)il[2 * h], (float)il[2 * h + 1]} * sc + (f2){blv[2 * h], blv[2 * h + 1]};
                        g = (f2){fminf(g.x, 7.0f), fminf(g.y, 7.0f)}; l = (f2){__builtin_amdgcn_fmed3f(l.x, -7.0f, 7.0f), __builtin_amdgcn_fmed3f(l.y, -7.0f, 7.0f)};
                        const f2 t = g * (-1.702f * 1.44269504f);
                        const f2 den = (f2){__builtin_amdgcn_exp2f(t.x), __builtin_amdgcn_exp2f(t.y)} + 1.0f;
                        const f2 r = {__builtin_amdgcn_rcpf(den.x), __builtin_amdgcn_rcpf(den.y)};
                        const f2 o2 = (g * r) * (l * ainv + ainv);
                        const f2 q2 = (f2){__builtin_amdgcn_fmed3f(o2.x, -127.f, 127.f), __builtin_amdgcn_fmed3f(o2.y, -127.f, 127.f)} + 12582912.f;
                        o[4 * n + 2 * h] = q2.x; o[4 * n + 2 * h + 1] = q2.y; } }
                v2u qv; qv.x = pack4b(o[0], o[1], o[2], o[3]); qv.y = pack4b(o[4], o[5], o[6], o[7]); *(v2u*)rowp = qv; }
    }
};
struct EpiDown {
    static constexpr bool PERM = true, AFTER_DRAIN = false;
    const float* bd; const float* sw; const float* asc; const float* wsc; bf16* YS;
    __device__ __forceinline__ void operator()(const pg8::f32x4 (&acc)[2][2][4][2], const pg8::Unit& u, int wr, int wc, int fr, int fq) const {
        const int e = u.pn >> 3, j = u.pn & 7, row0 = (u.pm & 0xffff) * 128 + wr * 64 + fr, col0 = j * 256 + wc * 32 + 8 * fq; const bool full = (u.pm >> 17) & 1;
        const float* bp = bd + (size_t)e * 2048 + col0; const float ws = wsc[64 + e];
        pg8::f32x4 bv[2][2];
#pragma unroll
        for (int bj = 0; bj < 2; ++bj)
#pragma unroll
            for (int n = 0; n < 2; ++n) bv[bj][n] = *(const pg8::f32x4*)(bp + bj * 128 + 4 * n);
#pragma unroll
        for (int ai = 0; ai < 2; ++ai) if (ai == 0 || full)
#pragma unroll
            for (int m = 0; m < 4; ++m) { const int row = row0 + ai * 128 + m * 16; const float wt = sw[row], sc = asc[row] * ws; bf16* rowp = YS + (size_t)row * 2048 + col0;
#pragma unroll
                for (int bj = 0; bj < 2; ++bj) { const pg8::i32x4 i0 = __builtin_bit_cast(pg8::i32x4, acc[ai][bj][m][0]), i1 = __builtin_bit_cast(pg8::i32x4, acc[ai][bj][m][1]);
                    const pg8::f32x4 v0 = ((pg8::f32x4){(float)i0[0], (float)i0[1], (float)i0[2], (float)i0[3]} * sc + bv[bj][0]) * wt, v1 = ((pg8::f32x4){(float)i1[0], (float)i1[1], (float)i1[2], (float)i1[3]} * sc + bv[bj][1]) * wt;
                    v4u w; w.x = pk2(v0[0], v0[1]); w.y = pk2(v0[2], v0[3]); w.z = pk2(v1[0], v1[1]); w.w = pk2(v1[2], v1[3]);
                    *(v4u*)(rowp + bj * 128) = w; } }
    }
};
__device__ __forceinline__ void tr_item_q(const float* __restrict__ W, int N, unsigned char* __restrict__ WT, int Kb, int k0, int n0, int drow0, float inv, LAS float* scr, int lane) {
    const float* src = W + (size_t)k0 * N + n0 + lane;
    float v[64];
#pragma unroll
    for (int i = 0; i < 64; ++i) v[i] = src[(size_t)i * N];
#pragma unroll
    for (int i = 0; i < 64; ++i) scr[i * 65 + lane] = v[i];
    LDS_WAIT();
#pragma unroll
    for (int j = 0; j < 4; ++j) { const int n = (lane >> 2) + 16 * j; const LAS float* q = scr + (16 * (lane & 3)) * 65 + n;
        v4u o; o.x = q8x4(q[0 * 65] * inv, q[1 * 65] * inv, q[2 * 65] * inv, q[3 * 65] * inv); o.y = q8x4(q[4 * 65] * inv, q[5 * 65] * inv, q[6 * 65] * inv, q[7 * 65] * inv);
        o.z = q8x4(q[8 * 65] * inv, q[9 * 65] * inv, q[10 * 65] * inv, q[11 * 65] * inv); o.w = q8x4(q[12 * 65] * inv, q[13 * 65] * inv, q[14 * 65] * inv, q[15 * 65] * inv);
        *(v4u*)(WT + (size_t)(drow0 + n) * Kb + k0 + 16 * (lane & 3)) = o; }
    LDS_WAIT();
}
template <bool NT>
__device__ __forceinline__ void tr_item(const float* __restrict__ W, int N, bf16* __restrict__ WT, int K, int k0, int n0, int drow0, LAS float* scr, int lane) {
    const float* src = W + (size_t)k0 * N + n0 + lane;
    float v[64];
#pragma unroll
    for (int i = 0; i < 64; ++i) v[i] = NT ? __builtin_nontemporal_load(src + (size_t)i * N) : src[(size_t)i * N];
#pragma unroll
    for (int i = 0; i < 64; ++i) scr[i * 65 + lane] = v[i];
    LDS_WAIT();
    const int c = lane & 7;
#pragma unroll
    for (int j = 0; j < 8; ++j) { const int n = (lane >> 3) + 8 * j; const LAS float* s = scr + (8 * c) * 65 + n;
        v4u o; o.x = pk2(s[0 * 65], s[1 * 65]); o.y = pk2(s[2 * 65], s[3 * 65]); o.z = pk2(s[4 * 65], s[5 * 65]); o.w = pk2(s[6 * 65], s[7 * 65]);
        v4u* dst = (v4u*)(WT + (size_t)(drow0 + n) * K + k0 + 8 * c);
        if (NT) __builtin_nontemporal_store(o, dst); else *dst = o; }
    LDS_WAIT();
}
__device__ __forceinline__ int win_drow(int n0) {
    if (n0 < 5120) return n0;
    if (n0 < 5184) return 9216 + (n0 - 5120);
    if (n0 < 7232) { const int j = n0 - 5184; return (20 + (j >> 7)) * 256 + (j & 127); }
    const int j = n0 - 7232; return (20 + (j >> 7)) * 256 + 128 + (j & 127);
}
__device__ __forceinline__ int gu_drow(int n0) { if (n0 < 2048) return (n0 >> 7) * 256 + (n0 & 127); const int j = n0 - 2048; return (j >> 7) * 256 + 128 + (j & 127); }
constexpr int CV_SCR = 16896;
constexpr int IT_OUT = 64 * 32, IT_GU = 32 * 64 * 32, IT_D = 32 * 32 * 32, NIT_B = IT_GU + IT_D, IT_P4 = IT_GU / 4  ;
struct CvItem { const float* src; unsigned char* dst; int N; float inv, lim; int dp = 2048; };
__device__ __forceinline__ CvItem conv_decode(CArgs& A, int it) {
    unsigned char* ws = A.ws; int r = it; CvItem c;
    if (r < IT_GU) { const int e = r >> 11, rr = r & 2047, kb = rr >> 7, nb = rr & 127; c.N = 4096; { const float sc_ = ((const float*)(ws + WQ_WSC))[e]; c.inv = 1.0f / sc_; c.lim = 127.0f * sc_; }
        c.src = A.in[I_WGU] + (size_t)e * 2048 * 4096 + (size_t)(128 * kb) * 4096 + 32 * nb; c.dst = ws + WS_WGU + (size_t)e * 4096 * 2048 + (size_t)gu_drow(32 * nb) * 2048 + 128 * kb; return c; }
    r -= IT_GU;
    { const int e = r >> 10, rr = r & 1023, kb = rr >> 6, nb = rr & 63; c.N = 2048; { const float sc_ = ((const float*)(ws + WQ_WSC))[64 + e]; c.inv = 1.0f / sc_; c.lim = 127.0f * sc_; }
        c.src = A.in[I_WD] + (size_t)e * 2048 * 2048 + (size_t)(128 * kb) * 2048 + 32 * nb; c.dst = ws + WS_WD + (size_t)e * 2048 * 2048 + (size_t)(32 * nb) * 2048 + 128 * kb; }
    return c;
}
__device__ __forceinline__ unsigned q8x4c(float a, float b, float c, float d, float lim, float inv) {
    const unsigned ua = __float_as_uint(__builtin_fmaf(__builtin_amdgcn_fmed3f(a, -lim, lim), inv, 12582912.f)), ub = __float_as_uint(__builtin_fmaf(__builtin_amdgcn_fmed3f(b, -lim, lim), inv, 12582912.f)),
                   uc = __float_as_uint(__builtin_fmaf(__builtin_amdgcn_fmed3f(c, -lim, lim), inv, 12582912.f)), ud = __float_as_uint(__builtin_fmaf(__builtin_amdgcn_fmed3f(d, -lim, lim), inv, 12582912.f));
    return __builtin_amdgcn_perm(__builtin_amdgcn_perm(ud, uc, 0x0c0c0400u), __builtin_amdgcn_perm(ub, ua, 0x0c0c0400u), 0x05040100u);
}
#define CV_LOAD(v, c) do { const float* s_ = (c).src + (size_t)(16 * (lane >> 3)) * (c).N + 4 * (lane & 7); _Pragma("unroll") for (int i_ = 0; i_ < 16; ++i_) (v)[i_] = __builtin_nontemporal_load((const f4*)(s_ + (size_t)i_ * (c).N)); } while (0)
#define CV_FINISH(v, c) do { const float iv_ = (c).inv, lm_ = (c).lim; unsigned char* d_ = (c).dst + (size_t)(4 * (lane & 7)) * (c).dp + 16 * (lane >> 3); \
        _Pragma("unroll") for (int j_ = 0; j_ < 4; ++j_) { v4u o_; \
            o_.x = q8x4c((v)[0][j_], (v)[1][j_], (v)[2][j_], (v)[3][j_], lm_, iv_); o_.y = q8x4c((v)[4][j_], (v)[5][j_], (v)[6][j_], (v)[7][j_], lm_, iv_); \
            o_.z = q8x4c((v)[8][j_], (v)[9][j_], (v)[10][j_], (v)[11][j_], lm_, iv_); o_.w = q8x4c((v)[12][j_], (v)[13][j_], (v)[14][j_], (v)[15][j_], lm_, iv_); \
            __builtin_nontemporal_store(o_, (v4u*)(d_ + (size_t)j_ * (c).dp)); } } while (0)
__device__ __forceinline__ void conv_static(CArgs& A, int begin, int end, int rank, int nrank, LAS unsigned char* lds, int lane, int wave) {
    (void)lds; (void)wave;
    int it = begin + rank; if (it >= end) return;
    f4 va[16], vb[16];
    CvItem ca = conv_decode(A, it), cb = ca;
    CV_LOAD(va, ca);
#pragma unroll 1
    for (;;) {
        it += nrank; const bool more_b = it < end;
        if (more_b) { cb = conv_decode(A, it); CV_LOAD(vb, cb); }
        CV_FINISH(va, ca);
        if (!more_b) break;
        it += nrank; const bool more_a = it < end;
        if (more_a) { ca = conv_decode(A, it); CV_LOAD(va, ca); }
        CV_FINISH(vb, cb);
        if (!more_a) break;
    }
}

__device__ __forceinline__ void conv_simple(CArgs& A, int begin, int end, int rank, int nrank, int lane) {
#pragma unroll 1
    for (int it = begin + rank; it < end; it += nrank) { const CvItem c = conv_decode(A, it); f4 va[16]; CV_LOAD(va, c); CV_FINISH(va, c); }
}

__device__ __forceinline__ void p0_prologue(CArgs& A, LAS unsigned char* lds, int tid, int lane, int wave, int bx, int G) {
    unsigned char* ws = A.ws;
    if (bx < 32 && wave == 7) { const float* w = A.in[I_WGU] + (size_t)bx * 2048 * 4096 + lane; float ss = 0.f;
#pragma unroll 8
        for (int i = 0; i < 64; ++i) { const float v = w[(size_t)i * 4096]; ss += v * v; }
        ss = wave_sum(ss); if (lane == 0) ((float*)(ws + WQ_WSC))[bx] = WQ_CLIP * sqrtf(ss * (1.0f / 4096.0f)) * (1.0f / 127.0f); }
    if (bx < 32 && wave == 5) { const float* w = A.in[I_WD] + (size_t)bx * 2048 * 2048 + lane; float ss = 0.f;
#pragma unroll 8
        for (int i = 0; i < 64; ++i) { const float v = w[(size_t)i * 2048]; ss += v * v; }
        ss = wave_sum(ss); if (lane == 0) ((float*)(ws + WQ_WSC))[64 + bx] = WQ_CLIP * sqrtf(ss * (1.0f / 4096.0f)) * (1.0f / 127.0f); }
    if (bx == 32 && wave == 5) { const float* w = A.in[I_WOUT] + lane; float ss = 0.f;
#pragma unroll 8
        for (int i = 0; i < 64; ++i) { const float v = w[(size_t)i * 2048]; ss += v * v; }
        ss = wave_sum(ss); if (lane == 0) ((float*)(ws + WQ_WSC))[33] = WQ_CLIP * sqrtf(ss * (1.0f / 4096.0f)) * (1.0f / 127.0f); }
    if (bx == 0 && wave == 6) { const float* w = A.in[I_WIN] + lane; float ss = 0.f;
#pragma unroll 8
        for (int i = 0; i < 64; ++i) { const float v = w[(size_t)i * NIN]; ss += v * v; }
        ss = wave_sum(ss); const float sc = WQ_CLIP * sqrtf(ss * (1.0f / 4096.0f)) * (1.0f / 127.0f);
        if (lane == 0 && bx == 0) ((float*)(ws + WQ_WSC))[32] = sc; }
    LAS float* st = (LAS float*)lds;
    LAS float* part = (LAS float*)(lds + 40960);
    for (int i = tid; i < 5 * 2048; i += 512) { const int r = i >> 11, k = i & 2047; const float v = r < 4 ? A.in[I_C][r * 2048 + k] : A.in[I_CCTX][k]; st[i] = v / (1.0f + __expf(-v)); }
    __syncthreads();
    for (int cb = bx; cb < 192; cb += G) {
        const int n0 = 64 * cb, k0 = 256 * wave;
        float acc[5] = {0.f, 0.f, 0.f, 0.f, 0.f};
        const float* wp = A.in[I_WMOD] + (size_t)k0 * NMOD + n0 + lane;
#pragma unroll 1
        for (int kk = 0; kk < 256; kk += 32) {
            float wv[32];
#pragma unroll
            for (int u = 0; u < 32; ++u) wv[u] = __builtin_nontemporal_load(wp + (size_t)(kk + u) * NMOD);
#pragma unroll
            for (int u = 0; u < 32; ++u)
#pragma unroll
                for (int r = 0; r < 5; ++r) acc[r] += st[r * 2048 + k0 + kk + u] * wv[u];
        }
#pragma unroll
        for (int r = 0; r < 5; ++r) part[(wave * 5 + r) * 64 + lane] = acc[r];
        __syncthreads();
        if (tid < 320) { const int r = tid >> 6, ln = tid & 63; float s = A.in[I_BMOD][n0 + ln];
#pragma unroll
            for (int w = 0; w < 8; ++w) s += part[(w * 5 + r) * 64 + ln];
            ((float*)(ws + WS_MOD))[r * NMOD + n0 + ln] = s; }
        __syncthreads();
    }
    { bf16* hi = (bf16*)(ws + WS_WRT); bf16* lo = hi + 65536; const float* wr = A.in[I_WR];
      for (int i = bx * 512 + tid; i < 65536; i += G * 512) { const int e = i >> 11, k = i & 2047; const float v = wr[k * 32 + e];
          const unsigned h = pk2(v, 0.f) & 0xffffu; const float r = v - __uint_as_float(h << 16); hi[i] = (bf16)h; lo[i] = (bf16)(pk2(r, 0.f) & 0xffffu); } }
    { v4u* z = (v4u*)(ws + WS_WIN + (size_t)NIN * 2048); const v4u zero = {0u, 0u, 0u, 0u};
      for (int i = bx * 512 + tid; i < 24576; i += G * 512) z[i] = zero; }
    __syncthreads();
}

__device__ __forceinline__ void p1_norm(CArgs& A, LAS unsigned char* lds, int lane, int wave, int bx, int G) {
    const float* mod = (const float*)(A.ws + WS_MOD); unsigned char* HA = A.ws + WS_HA; float* hsc = (float*)(A.ws + WQ_HASC); const float* gmix = A.in[I_GMIX];
#pragma unroll 1
    for (int row = bx * 8 + wave; row < MA; row += G * 8) {
        const float* src; const float* sh;
        if (row < M) { src = A.in[I_X] + (size_t)row * D; sh = mod + (size_t)(row >> 11) * NMOD; } else { src = A.in[I_CTX] + (size_t)(row - M) * D; sh = mod + (size_t)4 * NMOD; }
        const float* sc = sh + 2048;
        f4 v[4][2]; float ss = 0.f;
#pragma unroll
        for (int j = 0; j < 4; ++j) { const int c = 8 * lane + 512 * j; v[j][0] = *(const f4*)(src + c); v[j][1] = *(const f4*)(src + c + 4);
            ss += (v[j][0].x * v[j][0].x + v[j][0].y * v[j][0].y) + (v[j][0].z * v[j][0].z + v[j][0].w * v[j][0].w) + (v[j][1].x * v[j][1].x + v[j][1].y * v[j][1].y) + (v[j][1].z * v[j][1].z + v[j][1].w * v[j][1].w); }
        const float rstd = 1.0f / sqrtf(wave_sum(ss) * (1.0f / D) + EPS);
        float amax = 0.f;
#pragma unroll
        for (int j = 0; j < 4; ++j) { const int c = 8 * lane + 512 * j;
#pragma unroll
            for (int q = 0; q < 2; ++q) { const f4 g = *(const f4*)(gmix + c + 4 * q), s = *(const f4*)(sc + c + 4 * q), h = *(const f4*)(sh + c + 4 * q);
#pragma unroll
                for (int i = 0; i < 4; ++i) { const float o = v[j][q][i] * rstd * g[i] * (1.0f + s[i]) + h[i]; v[j][q][i] = o; amax = fmaxf(amax, fabsf(o)); } } }
#pragma unroll
        for (int o = 1; o < 64; o <<= 1) amax = fmaxf(amax, __shfl_xor(amax, o));
        const float inv = amax > 0.f ? 127.0f / amax : 0.f;
        if (lane == 0) hsc[row] = amax * (1.0f / 127.0f);
#pragma unroll
        for (int j = 0; j < 4; ++j) { const int c = 8 * lane + 512 * j; const f4 a = v[j][0], b = v[j][1];
            v2u qv; qv.x = q8x4(a[0] * inv, a[1] * inv, a[2] * inv, a[3] * inv); qv.y = q8x4(b[0] * inv, b[1] * inv, b[2] * inv, b[3] * inv);
            *(v2u*)(HA + (size_t)row * D + c) = qv; }
    }
    unsigned char* ws = A.ws;
    LAS float* scr = (LAS float*)(lds + wave * CV_SCR);
    const int NGW = G * 8, gw = NGW - 1 - (bx * 8 + wave);
    { const float wsc_ = ((const float*)(ws + WQ_WSC))[32]; CvItem c; c.N = NIN; c.inv = 1.0f / wsc_; c.lim = 127.0f * wsc_;
#pragma unroll 1
      for (int it = gw; it < 16 * 290; it += NGW) { const int kb = it / 290, nb = it % 290; f4 va[16];
          c.src = A.in[I_WIN] + (size_t)(128 * kb) * NIN + 32 * nb; c.dst = ws + WS_WIN + (size_t)(win_drow(64 * (nb >> 1)) + 32 * (nb & 1)) * 2048 + 128 * kb;
          CV_LOAD(va, c); CV_FINISH(va, c); } }
    { const float wso_ = ((const float*)(ws + WQ_WSC))[33]; CvItem c; c.N = 2048; c.inv = 1.0f / wso_; c.lim = 127.0f * wso_; c.dp = 4096;
#pragma unroll 1
      for (int it = gw; it < IT_OUT; it += NGW) { const int kb = it >> 6, nb = it & 63; f4 va[16];
          { const float f_ = kb < 16 ? MIXF_S : MIXF_C; c.inv = 1.0f / (wso_ * f_); c.lim = 127.0f * wso_ * f_; }
          c.src = A.in[I_WOUT] + (size_t)(128 * kb) * 2048 + 32 * nb; c.dst = ws + WS_WOUT + (size_t)(32 * nb) * 4096 + 128 * kb;
          CV_LOAD(va, c); CV_FINISH(va, c); } }
    __syncthreads();
}

__device__ __forceinline__ void p3_ssdconv(CArgs& A, int tid, int bx, int G) {
    typedef unsigned v3u __attribute__((ext_vector_type(3)));
    const bf16* XBC = (const bf16*)(A.ws + WS_XBC); bf16* XC = (bf16*)(A.ws + WS_XBCC);
    const int c = 6 * tid;
    f2 w0[3], w1[3], w2[3], bb[3];
#pragma unroll
    for (int i = 0; i < 3; ++i) { w0[i] = *(const f2*)(A.in[I_SCW] + c + 2 * i); w1[i] = *(const f2*)(A.in[I_SCW] + DXBC + c + 2 * i); w2[i] = *(const f2*)(A.in[I_SCW] + 2 * DXBC + c + 2 * i); bb[i] = *(const f2*)(A.in[I_SCB] + c + 2 * i); }
    const v3u zero = {0u, 0u, 0u};
#pragma unroll 1
    for (int strip = bx; strip < 768; strip += G) {
        const int r0 = 12 * strip;
        v3u raw[14];
#pragma unroll
        for (int i = 0; i < 14; ++i) { const int r = r0 - 1 + i; raw[i] = (r >= 0 && r < MA) ? *(const v3u*)(XBC + (size_t)r * DXBC + c) : zero; }
#pragma unroll
        for (int i = 0; i < 12; ++i) { const int r = r0 + i;
            int t, L; if (r < M) { t = r & 2047; L = 2048; } else { t = (r - M) & 255; L = 256; }
            const v3u pu = t > 0 ? raw[i] : zero, qu = raw[i + 1], nu = t < L - 1 ? raw[i + 2] : zero;
            v3u ov;
#pragma unroll
            for (int k = 0; k < 3; ++k) {
                const f2 x = w0[k] * (f2){bflo(pu[k]), bfhi(pu[k])} + (w1[k] * (f2){bflo(qu[k]), bfhi(qu[k])} + (w2[k] * (f2){bflo(nu[k]), bfhi(nu[k])} + bb[k]));
                const f2 tt = x * (-1.44269504f);
                const f2 den = (f2){__builtin_amdgcn_exp2f(tt.x), __builtin_amdgcn_exp2f(tt.y)} + 1.0f;
                const f2 o2 = x * (f2){__builtin_amdgcn_rcpf(den.x), __builtin_amdgcn_rcpf(den.y)};
                ov[k] = pk2(o2.x, o2.y); }
            *(v3u*)(XC + (size_t)r * DXBC + c) = ov; }
    }
}

__device__ __forceinline__ void p3_confconv(CArgs& A, LAS unsigned char* lds, int tid, int bx, int G) {
    const bf16* V = (const bf16*)(A.ws + WS_V); bf16* YC = (bf16*)(A.ws + WS_YC);
    LAS f2* tile = (LAS f2*)lds;
    const int cp = tid & 63, q = tid >> 6;
#pragma unroll 1
    for (int cb = bx; cb < 256; cb += G) {
        const int combo = cb >> 4, sub = cb & 15; const bool colconv = combo >= 8; const int cbase = 128 * combo;
        f2 w[31];
#pragma unroll
        for (int k = 0; k < 31; ++k) w[k] = *(const f2*)(A.in[I_CDW] + (size_t)k * 2048 + cbase + 2 * cp);
        const f2 bias = *(const f2*)(A.in[I_CDB] + cbase + 2 * cp);
#define TOK(b_, rr_, pos) ((b_) * 2048 + (colconv ? (((pos) & 31) * 64 + 2 * (rr_) + ((pos) >> 5)) : ((rr_) * 64 + (pos))))
        unsigned pf[8];
        { const int it = sub * 8, b = it >> 5, rr = it & 31;
#pragma unroll
          for (int i = 0; i < 8; ++i) pf[i] = *(const unsigned*)(V + (size_t)TOK(b, rr, q + 8 * i) * 2048 + cbase + 2 * cp); }
#pragma unroll 1
        for (int ii = 0; ii < 8; ++ii) {
            const int it = sub * 8 + ii, b = it >> 5, rr = it & 31;
            __syncthreads();
#pragma unroll
            for (int i = 0; i < 8; ++i) tile[(q + 8 * i) * 64 + cp] = (f2){bflo(pf[i]), bfhi(pf[i])};
            __syncthreads();
            if (ii < 7) { const int it2 = it + 1, b2 = it2 >> 5, rr2 = it2 & 31;
#pragma unroll
                for (int i = 0; i < 8; ++i) pf[i] = *(const unsigned*)(V + (size_t)TOK(b2, rr2, q + 8 * i) * 2048 + cbase + 2 * cp); }
            const int p0 = 8 * q, lo = colconv ? (q >> 2) * 32 : 0, hi = colconv ? lo + 32 : 64;
            f2 o[8];
#pragma unroll
            for (int j = 0; j < 8; ++j) o[j] = bias;
#pragma unroll
            for (int d = 0; d < 38; ++d) {
                const int idx = p0 - 15 + d;
                f2 val = {0.f, 0.f};
                if (idx >= lo && idx < hi) val = tile[idx * 64 + cp];
#pragma unroll
                for (int j = 0; j < 8; ++j) { const int k = d - j; if (k >= 0 && k < 31) { o[j].x += w[k].x * val.x; o[j].y += w[k].y * val.y; } }
            }
#pragma unroll
            for (int j = 0; j < 8; ++j) { const int pos = p0 + j; *(unsigned*)(YC + (size_t)TOK(b, rr, pos) * 2048 + cbase + 2 * cp) = pk2(o[j].x, o[j].y); }
        }
#undef TOK
    }
}
#define MFMA32(a, b, c) __builtin_amdgcn_mfma_f32_32x32x16_bf16((a), (b), (c), 0, 0, 0)
constexpr int SRS = 272;
constexpr int SXP = 192;
constexpr int S_BM = 0, S_CM = 32768, S_X = 67584, S_XH = 92160, S_PB = 116736, S_MT = 134144, S_TAB = 159744;
constexpr int SMP = 80, SMT = 32 * SMP;
static_assert(S_TAB + 1024 <= TAB_OFF, "scan images below the persistent LDS tables");
__device__ __forceinline__ unsigned bm_off(unsigned row, unsigned ch) { return 256u * row + 16u * (ch ^ (((row & 3u) << 2) | ((row >> 2) & 3u))); }
#define TR4(d0, d1, d2, d3, addr, o0, o1, o2, o3) asm volatile("ds_read_b64_tr_b16 %0, %4 offset:%5\n\tds_read_b64_tr_b16 %1, %4 offset:%6\n\tds_read_b64_tr_b16 %2, %4 offset:%7\n\tds_read_b64_tr_b16 %3, %4 offset:%8\n\ts_waitcnt lgkmcnt(0)" \
        : "=&v"(d0), "=&v"(d1), "=&v"(d2), "=&v"(d3) : "v"(addr), "n"(o0), "n"(o1), "n"(o2), "n"(o3) : "memory")
#define TR8(a00, a01, a10, a11, b00, b01, b10, b11, addrA, oA0, oA1, oA2, oA3, addrB0, addrB1, oB0, oB1) asm volatile( \
        "ds_read_b64_tr_b16 %0, %8 offset:%11\n\tds_read_b64_tr_b16 %1, %8 offset:%12\n\tds_read_b64_tr_b16 %2, %8 offset:%13\n\tds_read_b64_tr_b16 %3, %8 offset:%14\n\t" \
        "ds_read_b64_tr_b16 %4, %9 offset:%15\n\tds_read_b64_tr_b16 %5, %10 offset:%15\n\tds_read_b64_tr_b16 %6, %9 offset:%16\n\tds_read_b64_tr_b16 %7, %10 offset:%16\n\ts_waitcnt lgkmcnt(0)" \
        : "=&v"(a00), "=&v"(a01), "=&v"(a10), "=&v"(a11), "=&v"(b00), "=&v"(b01), "=&v"(b10), "=&v"(b11) \
        : "v"(addrA), "v"(addrB0), "v"(addrB1), "n"(oA0), "n"(oA1), "n"(oA2), "n"(oA3), "n"(oB0), "n"(oB1) : "memory")
__device__ __forceinline__ void p4_scan(CArgs& A, LAS unsigned char* lds, int tid, int lane, int wave, int bx, int G) {
    const bf16* XC = (const bf16*)(A.ws + WS_XBCC); const float* DT = (const float*)(A.ws + WS_DT);
    LAS float* sAc = (LAS float*)(lds + S_TAB); LAS float* sDt = sAc + 128;
    asm volatile("" : "+v"(lane), "+v"(tid));
    const int r = lane & 31, hh = lane >> 5, pt = wave & 1, lt = wave >> 1;
    const unsigned ldsb = (unsigned)(size_t)lds;
    const int tq = (lane & 15) >> 2, tp = lane & 3, tblk = (lane >> 4) & 1;
    const unsigned xcol = (unsigned)(32 * pt + 16 * tblk + 4 * tp) * 2u;
    const unsigned xa_natx = ldsb + S_X + (unsigned)(8 * hh + tq) * SXP + xcol;
    const unsigned xa_nat = ldsb + S_XH + (unsigned)(8 * hh + tq) * SXP + xcol;
    const unsigned bt0 = ldsb + S_BM + bm_off(8 * hh + tq, 4 * lt + 2 * tblk + (tp >> 1)) + 8 * (tp & 1);
    const unsigned bt1 = ldsb + S_BM + bm_off(8 * hh + 4 + tq, 4 * lt + 2 * tblk + (tp >> 1)) + 8 * (tp & 1);
    const unsigned bm_m = ((r & 3u) << 2) | ((r >> 2) & 3u);
    const int vcu = (G % 8 == 0) ? (bx % 8) * (G / 8) + bx / 8 : bx;
#pragma unroll 1
    for (int item = vcu; item < 256; item += G) {
        const int b = item >> 6, h = (item >> 1) & 31, dir = item & 1, g = h >> 3;
        const float Aneg = -expf(A.in[dir ? I_ALB : I_ALF][h]), dbias = A.in[dir ? I_DBB : I_DBF][h];
        bf16* Yout = (bf16*)(A.ws + (dir ? WS_YB : WS_YF));
        f16v stt;
#pragma unroll
        for (int i = 0; i < 16; ++i) stt[i] = 0.f;
        for (int i = tid; i < 64 * SRS / 4; i += 512) ((LAS unsigned*)(lds + S_PB))[i] = 0u;
#define ROWST(st_, l) (((st_) < 2 ? M + b * TC : b * T) + (dir ? (((st_) < 2 ? TC : T) - 1 - (128 * ((st_) < 2 ? (st_) : (st_) - 2) + (l))) : (128 * ((st_) < 2 ? (st_) : (st_) - 2) + (l))))
        v4u pfb[4], pfc[4], pfx[2]; float pfd0 = 0.f, pfd1 = 0.f;
#define PREFETCH(st_) do { \
            _Pragma("unroll") for (int i = 0; i < 4; ++i) { const int q = tid + 512 * i, rl = q >> 4, pc = q & 15; const bf16* src = XC + (size_t)ROWST(st_, rl) * DXBC + 2048 + 128 * g + 8 * pc; \
                pfb[i] = *(const v4u*)src; pfc[i] = *(const v4u*)(src + 512); } \
            { const int l = tid & 127, pq = tid >> 7; const bf16* src = XC + (size_t)ROWST(st_, l) * DXBC + 64 * h + 16 * pq; pfx[0] = *(const v4u*)src; pfx[1] = *(const v4u*)(src + 8); } \
            pfd0 = DT[(size_t)ROWST(st_, 2 * lane) * 64 + dir * 32 + h]; pfd1 = DT[(size_t)ROWST(st_, 2 * lane + 1) * 64 + dir * 32 + h]; } while (0)
        PREFETCH(0);
#pragma unroll 1
        for (int st = 0; st < 18; ++st) {
            const bool isctx = st < 2;
#define ROWOF(l) ROWST(st, l)
            __syncthreads();
            if (st > 0) {
                LAS bf16* d = (LAS bf16*)(lds + S_PB + (32 * pt + 4 * hh) * SRS + (32 * lt + r) * 2);
#pragma unroll
                for (int i = 0; i < 16; i += 2) { const unsigned u = pk2(stt[i], stt[i + 1]); const int p0 = (i & 3) + 8 * (i >> 2);
                    d[p0 * (SRS / 2)] = (bf16)(u & 0xffffu); d[(p0 + 1) * (SRS / 2)] = (bf16)(u >> 16); }
            }
            float sc0, sc1;
            { const int l0 = 2 * lane;
              const float x0 = pfd0 + dbias, x1 = pfd1 + dbias;
              const float d0 = x0 > 20.f ? x0 : __logf(1.0f + __expf(x0)), d1 = x1 > 20.f ? x1 : __logf(1.0f + __expf(x1));
              const float a0 = d0 * Aneg, a1 = d1 * Aneg;
              float incl = a0 + a1;
#pragma unroll
              for (int o = 1; o < 64; o <<= 1) { const float t = __shfl_up(incl, o); if (lane >= o) incl += t; }
              const float c1 = incl, c0 = incl - a1, tot = __shfl(incl, 63);
              sc0 = d0 * __expf(tot - c0); sc1 = d1 * __expf(tot - c1);
              if (wave == 0) { sAc[l0] = c0; sAc[l0 + 1] = c1; sDt[l0] = d0; sDt[l0 + 1] = d1; } }
#pragma unroll
            for (int i = 0; i < 4; ++i) { const int q = tid + 512 * i, rl = q >> 4, pc = q & 15;
                *(LAS v4u*)(lds + S_BM + bm_off(rl, pc)) = pfb[i]; *(LAS v4u*)(lds + S_CM + rl * SRS + pc * 16) = pfc[i]; }
            { const int l = tid & 127, pq = tid >> 7, src = (wave & 1) * 32 + (lane >> 1);
              const float e0 = __shfl(sc0, src), e1 = __shfl(sc1, src), sl = (lane & 1) ? e1 : e0;
#pragma unroll
              for (int i = 0; i < 2; ++i) { const int off = l * SXP + (16 * pq + 8 * i) * 2; float f[8]; unpack8(pfx[i], f);
                  *(LAS v4u*)(lds + S_X + off) = pfx[i];
#pragma unroll
                  for (int e = 0; e < 8; ++e) f[e] *= sl;
                  *(LAS v4u*)(lds + S_XH + off) = pack8(f); } }
            if (st == 2 * ((bx >> 3) & 7) + 2) conv_simple(A, IT_GU - IT_P4 + ((bx >> 3) & 7) * (IT_P4 / 8), IT_GU - IT_P4 + (((bx >> 3) & 7) + 1) * (IT_P4 / 8), (((bx >> 6) << 3) + (bx & 7)) * 8 + wave, 256, lane);
            __syncthreads();
            if (st < 17) PREFETCH(st + 1);
            if (!isctx) {
#pragma unroll 1
                for (int tix = wave; tix < 10; tix += 8) {
                    const int lt_a = tix >= 6 ? 3 : (tix >= 3 ? 2 : (tix >= 1 ? 1 : 0)), st_a = tix - ((lt_a * (lt_a + 1)) >> 1);
                    h8 cfa[8], afa[8];
                    const LAS unsigned char* brow = lds + S_BM + 256 * (32 * st_a + r);
#pragma unroll
                    for (int k = 0; k < 8; ++k) { cfa[k] = *(const LAS h8*)(lds + S_CM + (32 * lt_a + r) * SRS + (16 * k + 8 * hh) * 2); afa[k] = *(const LAS h8*)(brow + 16 * ((unsigned)(2 * k + hh) ^ bm_m)); }
                    f4 tac[4], tdt[4];
#pragma unroll
                    for (int g4 = 0; g4 < 4; ++g4) { tac[g4] = *(const LAS f4*)(sAc + 32 * st_a + 8 * g4 + 4 * hh); tdt[g4] = *(const LAS f4*)(sDt + 32 * st_a + 8 * g4 + 4 * hh); }
                    const float acl_a = sAc[32 * lt_a + r];
                    LDS_WAIT();
                    f16v gt;
#pragma unroll
                    for (int i = 0; i < 16; ++i) gt[i] = 0.f;
#pragma unroll
                    for (int k = 0; k < 8; ++k) gt = MFMA32(afa[k], cfa[k], gt);
                    const bool diag = (st_a == lt_a);
#pragma unroll
                    for (int i = 0; i < 16; ++i) { const int sl = (i & 3) + 8 * (i >> 2) + 4 * hh;
                        const float f = __expf(acl_a - tac[i >> 2][i & 3]) * tdt[i >> 2][i & 3];
                        gt[i] = (diag && sl > r) ? 0.f : gt[i] * f; }
                    LAS unsigned char* mt = lds + S_MT + tix * SMT + r * SMP + 8 * hh;
#pragma unroll
                    for (int g4 = 0; g4 < 4; ++g4) { v2u o; o.x = pk2(gt[4 * g4], gt[4 * g4 + 1]); o.y = pk2(gt[4 * g4 + 2], gt[4 * g4 + 3]); *(LAS v2u*)(mt + 16 * g4) = o; }
                }
            }
            __syncthreads();
            if (!isctx) {
                f16v y;
#pragma unroll
                for (int i = 0; i < 16; ++i) y[i] = 0.f;
                { h8 cf[8], af[8];
#pragma unroll
                  for (int k = 0; k < 8; ++k) { cf[k] = *(const LAS h8*)(lds + S_CM + (32 * lt + r) * SRS + (16 * k + 8 * hh) * 2); af[k] = *(const LAS h8*)(lds + S_PB + (32 * pt + r) * SRS + (16 * k + 8 * hh) * 2); }
                  LDS_WAIT();
#pragma unroll
                  for (int k = 0; k < 8; ++k) y = MFMA32(af[k], cf[k], y); }
                const float el = __expf(sAc[32 * lt + r]);
#pragma unroll
                for (int i = 0; i < 16; ++i) y[i] *= el;
#pragma unroll 1
                for (int s_t = 0; s_t <= lt; ++s_t) {
                    const LAS unsigned char* mt = lds + S_MT + (((lt * (lt + 1)) >> 1) + s_t) * SMT + r * SMP + 16 * hh;
                    const h8 b0 = *(const LAS h8*)mt, b1 = *(const LAS h8*)(mt + 32);
                    v2u xa0, xa1, xa2, xa3;
                    { const unsigned xad = xa_natx + (unsigned)(32 * s_t) * SXP; TR4(xa0, xa1, xa2, xa3, xad, 0, 4 * SXP, 16 * SXP, 20 * SXP); }
                    v4u pa; pa.x = xa0.x; pa.y = xa0.y; pa.z = xa1.x; pa.w = xa1.y;
                    y = MFMA32(__builtin_bit_cast(h8, pa), b0, y);
                    pa.x = xa2.x; pa.y = xa2.y; pa.z = xa3.x; pa.w = xa3.y;
                    y = MFMA32(__builtin_bit_cast(h8, pa), b1, y);
                }
                bf16* yrow = Yout + (size_t)ROWOF(32 * lt + r) * 2048 + 64 * h + 32 * pt + 4 * hh;
#pragma unroll
                for (int gq = 0; gq < 4; ++gq) { v2u o; o.x = pk2(y[4 * gq], y[4 * gq + 1]); o.y = pk2(y[4 * gq + 2], y[4 * gq + 3]); *(v2u*)(yrow + 8 * gq) = o; }
            }
            if (st < 17) {
                const float dA = __expf(sAc[127]);
#pragma unroll
                for (int i = 0; i < 16; ++i) stt[i] *= dA;
#pragma unroll
                for (int kh = 0; kh < 4; ++kh) {
                    v2u a00, a01, a10, a11, b00, b01, b10, b11;
                    TR8(a00, a01, a10, a11, b00, b01, b10, b11, xa_nat, (32 * kh) * SXP, (32 * kh + 4) * SXP, (32 * kh + 16) * SXP, (32 * kh + 20) * SXP, bt0, bt1, 8192 * kh, 8192 * kh + 4096);
                    v4u fa, fb;
                    fa.x = a00.x; fa.y = a00.y; fa.z = a01.x; fa.w = a01.y; fb.x = b00.x; fb.y = b00.y; fb.z = b01.x; fb.w = b01.y;
                    stt = MFMA32(__builtin_bit_cast(h8, fa), __builtin_bit_cast(h8, fb), stt);
                    fa.x = a10.x; fa.y = a10.y; fa.z = a11.x; fa.w = a11.y; fb.x = b10.x; fb.y = b10.y; fb.z = b11.x; fb.w = b11.y;
                    stt = MFMA32(__builtin_bit_cast(h8, fa), __builtin_bit_cast(h8, fb), stt);
                }
            }
#undef ROWOF
        }
#undef PREFETCH
#undef ROWST
        __syncthreads();
    }
}

__device__ __forceinline__ void p5_mix(CArgs& A, int lane, int wave, int bx, int G) {
    const bf16* YF = (const bf16*)(A.ws + WS_YF); const bf16* YB = (const bf16*)(A.ws + WS_YB); const bf16* XC = (const bf16*)(A.ws + WS_XBCC);
    const bf16* Z = (const bf16*)(A.ws + WS_Z); const bf16* YC = (const bf16*)(A.ws + WS_YC); unsigned char* MIX = A.ws + WS_MIX; float* msc = (float*)(A.ws + WQ_MSC);
#pragma unroll 1
    for (int row = bx * 8 + wave; row < M; row += G * 8) {
        float ys[4][8], amax = 0.f;
#pragma unroll
        for (int j = 0; j < 4; ++j) { const int c = 8 * lane + 512 * j; const float dsk = A.in[I_DSKIP][(lane >> 3) + 8 * j];
            float yf[8], yb[8], xs[8], z[8];
            unpack8(*(const v4u*)(YF + (size_t)row * 2048 + c), yf); unpack8(*(const v4u*)(YB + (size_t)row * 2048 + c), yb);
            unpack8(*(const v4u*)(XC + (size_t)row * DXBC + c), xs); unpack8(*(const v4u*)(Z + (size_t)row * 2048 + c), z);
            float ss = 0.f;
#pragma unroll
            for (int i = 0; i < 8; ++i) { ys[j][i] = (yf[i] + yb[i] + dsk * xs[i]) * siluf(z[i]); ss += ys[j][i] * ys[j][i]; }
            const float rstd = 1.0f / sqrtf(wave_sum(ss) * (1.0f / 512.0f) + EPS);
            const f4 g0 = *(const f4*)(A.in[I_SNG] + c), g1 = *(const f4*)(A.in[I_SNG] + c + 4);
#pragma unroll
            for (int i = 0; i < 4; ++i) { ys[j][i] = ys[j][i] * (rstd * MIXF_S) * g0[i]; ys[j][4 + i] = ys[j][4 + i] * (rstd * MIXF_S) * g1[i]; amax = fmaxf(amax, fmaxf(fabsf(ys[j][i]), fabsf(ys[j][4 + i]))); } }
        float v[4][8]; float s = 0.f;
#pragma unroll
        for (int j = 0; j < 4; ++j) { unpack8(*(const v4u*)(YC + (size_t)row * 2048 + 8 * lane + 512 * j), v[j]);
#pragma unroll
            for (int i = 0; i < 8; ++i) s += v[j][i]; }
        const float mu = wave_sum(s) * (1.0f / 2048.0f); float q = 0.f;
#pragma unroll
        for (int j = 0; j < 4; ++j)
#pragma unroll
            for (int i = 0; i < 8; ++i) { v[j][i] -= mu; q += v[j][i] * v[j][i]; }
        const float rs = 1.0f / sqrtf(wave_sum(q) * (1.0f / 2048.0f) + EPS);
#pragma unroll
        for (int j = 0; j < 4; ++j) { const int c = 8 * lane + 512 * j;
#pragma unroll
            for (int qq = 0; qq < 2; ++qq) { const f4 g = *(const f4*)(A.in[I_CLG] + c + 4 * qq), bb = *(const f4*)(A.in[I_CLB] + c + 4 * qq);
#pragma unroll
                for (int i = 0; i < 4; ++i) { const float o = MIXF_C * siluf(v[j][4 * qq + i] * rs * g[i] + bb[i]); v[j][4 * qq + i] = o; amax = fmaxf(amax, fabsf(o)); } } }
#pragma unroll
        for (int o = 1; o < 64; o <<= 1) amax = fmaxf(amax, __shfl_xor(amax, o));
        const float inv = amax > 0.f ? 127.0f / amax : 0.f;
        if (lane == 0) msc[row] = amax * (1.0f / 127.0f);
#pragma unroll
        for (int j = 0; j < 4; ++j) { const int c = 8 * lane + 512 * j; v2u a, b;
            a.x = q8x4(ys[j][0] * inv, ys[j][1] * inv, ys[j][2] * inv, ys[j][3] * inv); a.y = q8x4(ys[j][4] * inv, ys[j][5] * inv, ys[j][6] * inv, ys[j][7] * inv);
            b.x = q8x4(v[j][0] * inv, v[j][1] * inv, v[j][2] * inv, v[j][3] * inv); b.y = q8x4(v[j][4] * inv, v[j][5] * inv, v[j][6] * inv, v[j][7] * inv);
            *(v2u*)(MIX + (size_t)row * 4096 + c) = a; *(v2u*)(MIX + (size_t)row * 4096 + 2048 + c) = b; }
    }
}
__device__ __forceinline__ void p7_router(CArgs& A, LAS unsigned char* lds, int tid, int lane, int wave, int bx, int G) {
    const bf16* X1 = (const bf16*)(A.ws + WS_X1); const float* mod = (const float*)(A.ws + WS_MOD);
    LAS unsigned char* h2l = lds + 20480; constexpr int H2P = 4112;
    const bf16* WH = (const bf16*)(A.ws + WS_WRT); const bf16* WL = WH + 65536;
    int* top_idx = (int*)(A.ws + WS_ROUTE + RT_IDX); float* top_w = (float*)(A.ws + WS_ROUTE + RT_W); int* bcnt = (int*)(A.ws + WS_ROUTE + RT_BCNT);
    LAS float* part = (LAS float*)lds;
    LAS int* cnt = (LAS int*)(lds + 16384);
    const float* gffn = A.in[I_GFFN]; unsigned char* H2Q = A.ws + WS_H2Q; float* HSC = (float*)(A.ws + WQ_HSC); float* HN = (float*)(A.ws + WQ_HN);
#pragma unroll 1
    for (int tg = bx; tg < 256; tg += G) {
        const int tok0 = 32 * tg;
        if (tid < 32) cnt[tid] = 0;
#pragma unroll 1
        for (int rp = 0; rp < 2; ++rp) { f4 v[2][4][2];
#pragma unroll
          for (int rr = 0; rr < 2; ++rr) { const bf16* src = X1 + (size_t)(tok0 + 4 * wave + 2 * rp + rr) * D;
#pragma unroll
              for (int j = 0; j < 4; ++j) { const int c = 8 * lane + 512 * j; const v4u u = *(const v4u*)(src + c);
                  v[rr][j][0] = (f4){bflo(u.x), bfhi(u.x), bflo(u.y), bfhi(u.y)}; v[rr][j][1] = (f4){bflo(u.z), bfhi(u.z), bflo(u.w), bfhi(u.w)}; } }
          const float* sh = mod + (size_t)(tok0 >> 11) * NMOD + 6144; const float* sc = sh + 2048;
#pragma unroll
          for (int rr = 0; rr < 2; ++rr) { const int row = tok0 + 4 * wave + 2 * rp + rr; float ss = 0.f;
#pragma unroll
              for (int j = 0; j < 4; ++j)
#pragma unroll
                  for (int q = 0; q < 2; ++q)
#pragma unroll
                      for (int i = 0; i < 4; ++i) ss += v[rr][j][q][i] * v[rr][j][q][i];
              const float rstd = 1.0f / sqrtf(wave_sum(ss) * (1.0f / D) + EPS);
              float amax = 0.f, hn2 = 0.f;
#pragma unroll
              for (int j = 0; j < 4; ++j) { const int c = 8 * lane + 512 * j;
#pragma unroll
                  for (int q = 0; q < 2; ++q) { const f4 g = *(const f4*)(gffn + c + 4 * q), s = *(const f4*)(sc + c + 4 * q), h = *(const f4*)(sh + c + 4 * q);
#pragma unroll
                      for (int i = 0; i < 4; ++i) { const float o = v[rr][j][q][i] * rstd * g[i] * (1.0f + s[i]) + h[i]; v[rr][j][q][i] = o; amax = fmaxf(amax, fabsf(o)); hn2 += o * o; } } }
              hn2 = wave_sum(hn2); if (lane == 0) HN[row] = sqrtf(hn2);
#pragma unroll
              for (int o = 1; o < 64; o <<= 1) amax = fmaxf(amax, __shfl_xor(amax, o));
              const float inv = amax > 0.f ? 127.0f / amax : 0.f;
              if (lane == 0) HSC[row] = amax * (1.0f / 127.0f);
#pragma unroll
              for (int j = 0; j < 4; ++j) { const int c = 8 * lane + 512 * j; const f4 a = v[rr][j][0], b = v[rr][j][1];
                  v4u w; w.x = pk2(a[0], a[1]); w.y = pk2(a[2], a[3]); w.z = pk2(b[0], b[1]); w.w = pk2(b[2], b[3]);
                  *(LAS v4u*)(h2l + (4 * wave + 2 * rp + rr) * H2P + 2 * c) = w;
                  v2u qv; qv.x = q8x4(a[0] * inv, a[1] * inv, a[2] * inv, a[3] * inv); qv.y = q8x4(b[0] * inv, b[1] * inv, b[2] * inv, b[3] * inv);
                  *(v2u*)(H2Q + (size_t)row * D + c) = qv; } } }
        __syncthreads();
        LAS float* part8 = (LAS float*)(lds + 32768);
        { const int kp = wave, i16 = lane & 15, kq = lane >> 4;
          pg8::f32x4 acc00 = {0.f, 0.f, 0.f, 0.f}, acc01 = acc00, acc10 = acc00, acc11 = acc00;
          const LAS unsigned char* ap = h2l + i16 * H2P + 2 * (256 * kp + 8 * kq);
          const bf16* bh0 = WH + (size_t)i16 * 2048 + 256 * kp + 8 * kq; const bf16* bl0 = WL + (size_t)i16 * 2048 + 256 * kp + 8 * kq;
#pragma unroll 4
          for (int s = 0; s < 8; ++s) { const h8 a0 = *(const LAS h8*)(ap + 64 * s), a1 = *(const LAS h8*)(ap + 16 * H2P + 64 * s);
              const h8 h0 = *(const h8*)(bh0 + 32 * s), l0 = *(const h8*)(bl0 + 32 * s), h1 = *(const h8*)(bh0 + 16 * 2048 + 32 * s), l1 = *(const h8*)(bl0 + 16 * 2048 + 32 * s);
              acc00 = __builtin_amdgcn_mfma_f32_16x16x32_bf16(a0, h0, acc00, 0, 0, 0); acc00 = __builtin_amdgcn_mfma_f32_16x16x32_bf16(a0, l0, acc00, 0, 0, 0);
              acc01 = __builtin_amdgcn_mfma_f32_16x16x32_bf16(a0, h1, acc01, 0, 0, 0); acc01 = __builtin_amdgcn_mfma_f32_16x16x32_bf16(a0, l1, acc01, 0, 0, 0);
              acc10 = __builtin_amdgcn_mfma_f32_16x16x32_bf16(a1, h0, acc10, 0, 0, 0); acc10 = __builtin_amdgcn_mfma_f32_16x16x32_bf16(a1, l0, acc10, 0, 0, 0);
              acc11 = __builtin_amdgcn_mfma_f32_16x16x32_bf16(a1, h1, acc11, 0, 0, 0); acc11 = __builtin_amdgcn_mfma_f32_16x16x32_bf16(a1, l1, acc11, 0, 0, 0); }
          __syncthreads();
          LAS float* p0 = part8 + ((0 * 8 + kp) * 16 + 4 * kq) * 32 + i16; LAS float* p1 = part8 + ((1 * 8 + kp) * 16 + 4 * kq) * 32 + i16;
#pragma unroll
          for (int i = 0; i < 4; ++i) { p0[i * 32] = acc00[i]; p0[i * 32 + 16] = acc01[i]; p1[i * 32] = acc10[i]; p1[i * 32 + 16] = acc11[i]; } }
        __syncthreads();
        if (tid < 32) { const int tile = tid >> 4, tl = tid & 15; float v[32];
#pragma unroll
            for (int e = 0; e < 32; ++e) { float s = A.in[I_BR][e];
#pragma unroll
                for (int kp = 0; kp < 8; ++kp) s += part8[((tile * 8 + kp) * 16 + tl) * 32 + e];
                v[e] = s; }
            unsigned taken = 0u; float tv[4]; int ti[4];
#pragma unroll
            for (int k = 0; k < 4; ++k) { float best = -3.0e38f; int bi = 0;
#pragma unroll
                for (int e = 0; e < 32; ++e) { const bool ok = !((taken >> e) & 1u) && (v[e] > best); best = ok ? v[e] : best; bi = ok ? e : bi; }
                taken |= 1u << bi; tv[k] = best; ti[k] = bi; }
            const float e1 = expf(tv[1] - tv[0]), e2 = expf(tv[2] - tv[0]), e3 = expf(tv[3] - tv[0]); const float inv = 1.0f / (1.0f + e1 + e2 + e3);
            const int tok = tok0 + tid;
            *(int4*)(top_idx + 4 * tok) = make_int4(ti[0], ti[1], ti[2], ti[3]);
            *(f4*)(top_w + 4 * tok) = (f4){inv, e1 * inv, e2 * inv, e3 * inv};
#pragma unroll
            for (int k = 0; k < 4; ++k) atomicAdd((int*)(cnt + ti[k]), 1); }
        __syncthreads();
        { int t2 = tid; asm volatile("" : "+v"(t2)); if (t2 < 32) bcnt[tg * 32 + t2] = cnt[t2]; }
        __syncthreads();
    }
}

__device__ __forceinline__ void p8_route(CArgs& A, LAS unsigned char* lds, int tid, int lane, int wave, int bx, int G) {
    const unsigned char* H2Q = A.ws + WS_H2Q; unsigned char* HS = A.ws + WS_HS; const float* HSC = (const float*)(A.ws + WQ_HSC); float* slot_sa = (float*)(A.ws + WQ_SSA); float* slot_asc = (float*)(A.ws + WS_ROUTE + RT_ASC); const float* HN = (const float*)(A.ws + WQ_HN); const float* WSC = (const float*)(A.ws + WQ_WSC);
    const int* top_idx = (const int*)(A.ws + WS_ROUTE + RT_IDX); const float* top_w = (const float*)(A.ws + WS_ROUTE + RT_W);
    int* tok_slot = (int*)(A.ws + WS_ROUTE + RT_SLOT); const int* bcnt = (const int*)(A.ws + WS_ROUTE + RT_BCNT); int* cumT_g = (int*)(A.ws + WS_ROUTE + RT_CUMT);
    float* slot_w = (float*)(A.ws + WS_ROUTE + RT_SW);
    LAS int* tab = (LAS int*)lds;
    LAS int* tot = (LAS int*)(lds + 32768);
    LAS int* off = tot + 32;
    LAS int* se = off + 40;
    LAS int* spos = se + 128;
    LAS int* base = spos + 128;
    LAS int* psum = base + 32;
    { int t2 = tid; asm volatile("" : "+v"(t2)); for (int i = t2; i < 8192; i += 512) tab[i] = bcnt[i]; }
    __syncthreads();
    { const int e = tid & 31, part = tid >> 5; int s = 0;
#pragma unroll
      for (int i = 0; i < 16; ++i) s += tab[(part * 16 + i) * 32 + e];
      psum[part * 32 + e] = s; }
    __syncthreads();
    if (tid < 32) { int s = 0;
#pragma unroll
        for (int p = 0; p < 16; ++p) s += psum[p * 32 + tid];
        tot[tid] = s; }
    __syncthreads();
    if (tid == 0) { int o = 0, hsum = 0, fsum = 0, nodd = 0;
        for (int e = 0; e < 32; ++e) { off[e] = o; const int m = (tot[e] + 127) >> 7;
            if (bx == 0) { cumT_g[e] = fsum; cumT_g[33 + e] = hsum; if (m & 1) cumT_g[67 + nodd] = e; }
            o += m << 7; hsum += m; fsum += m >> 1; nodd += m & 1; }
        off[32] = o; if (bx == 0) { cumT_g[32] = fsum; cumT_g[65] = hsum; cumT_g[66] = nodd; } }
    __syncthreads();
    for (int e = bx; e < 32; e += G) { const int r0 = off[e] + tot[e], r1 = off[e + 1]; const v4u zero = {0u, 0u, 0u, 0u};
        for (int row = r0 + wave; row < r1; row += 8) { v4u* d = (v4u*)(HS + (size_t)row * D);
#pragma unroll
            for (int j = 0; j < 2; ++j) d[lane + 64 * j] = zero;
            if (lane == 0) { slot_w[row] = 0.f; slot_sa[row] = 0.f; slot_asc[row] = 0.f; } } }
#pragma unroll 1
    for (int tg = bx; tg < 256; tg += G) {
        const int tok0 = 32 * tg;
        __syncthreads();
        if (tid < 32) { int s = 0; const int pfull = tg >> 4; for (int p = 0; p < pfull; ++p) s += psum[p * 32 + tid]; for (int b2 = pfull * 16; b2 < tg; ++b2) s += tab[b2 * 32 + tid]; base[tid] = s; }
        if (tid >= 64 && tid < 192) se[tid - 64] = top_idx[4 * tok0 + (tid - 64)];
        __syncthreads();
        if (tid < 128) { const int e = se[tid]; int rank = 0; for (int s2 = 0; s2 < tid; ++s2) rank += (se[s2] == e) ? 1 : 0;
            const int pos = off[e] + base[e] + rank; spos[tid] = pos; tok_slot[4 * tok0 + tid] = pos; slot_w[pos] = top_w[4 * tok0 + tid]; slot_sa[pos] = HSC[tok0 + (tid >> 2)];
            const float sg = HN[tok0 + (tid >> 2)] * WSC[e] * (127.0f / WQ_CLIP); slot_asc[pos] = 1.25f * (3.6f * sg + 4.6f * sg * sg) * (1.0f / 127.0f); }
        __syncthreads();
        { v4u rowv[4][2];
#pragma unroll
          for (int t = 0; t < 4; ++t) { const v4u* src = (const v4u*)(H2Q + (size_t)(tok0 + wave * 4 + t) * D); rowv[t][0] = src[lane]; rowv[t][1] = src[lane + 64]; }
#pragma unroll
          for (int t = 0; t < 4; ++t)
#pragma unroll
              for (int k = 0; k < 4; ++k) { v4u* d = (v4u*)(HS + (size_t)spos[wave * 16 + 4 * t + k] * D); d[lane] = rowv[t][0]; d[lane + 64] = rowv[t][1]; } }
    }
}

__device__ __forceinline__ void p11_final(CArgs& A, int lane, int wave, int bx, int G) {
    const bf16* X1 = (const bf16*)(A.ws + WS_X1); const float* mod = (const float*)(A.ws + WS_MOD); const bf16* YS = (const bf16*)(A.ws + WS_YS);
    const int* tok_slot = (const int*)(A.ws + WS_ROUTE + RT_SLOT); const float* gfin = A.in[I_GFIN];
#pragma unroll 1
    for (int row = bx * 8 + wave; row < M; row += G * 8) {
        const float* gf = mod + (size_t)(row >> 11) * NMOD + 10240; const int4 sl = *(const int4*)(tok_slot + 4 * row);
        const bf16* y0 = YS + (size_t)sl.x * D; const bf16* y1 = YS + (size_t)sl.y * D; const bf16* y2 = YS + (size_t)sl.z * D; const bf16* y3 = YS + (size_t)sl.w * D;
        float x2[4][8]; float ss = 0.f;
#pragma unroll
        for (int j = 0; j < 4; ++j) { const int c = 8 * lane + 512 * j; float a[8], b[8], cc[8], d[8], xr[8];
            unpack8(*(const v4u*)(X1 + (size_t)row * D + c), xr); unpack8(*(const v4u*)(y0 + c), a); unpack8(*(const v4u*)(y1 + c), b); unpack8(*(const v4u*)(y2 + c), cc); unpack8(*(const v4u*)(y3 + c), d);
#pragma unroll
            for (int q = 0; q < 2; ++q) { const f4 g = *(const f4*)(gf + c + 4 * q);
#pragma unroll
                for (int i = 0; i < 4; ++i) { const float m = (a[4 * q + i] + b[4 * q + i]) + (cc[4 * q + i] + d[4 * q + i]); const float v = xr[4 * q + i] + g[i] * m; x2[j][4 * q + i] = v; ss += v * v; } } }
        const float rstd = 1.0f / sqrtf(wave_sum(ss) * (1.0f / D) + EPS);
#pragma unroll
        for (int j = 0; j < 4; ++j) { const int c = 8 * lane + 512 * j;
#pragma unroll
            for (int q = 0; q < 2; ++q) { const f4 g = *(const f4*)(gfin + c + 4 * q); f4 o;
#pragma unroll
                for (int i = 0; i < 4; ++i) o[i] = x2[j][4 * q + i] * rstd * g[i];
                *(f4*)(A.out + (size_t)row * D + c + 4 * q) = o; } }
    }
}
constexpr int CW_CVQ = 64;
#ifndef CV_SPLIT
#define CV_XL 2464
#define CV_SPLIT ((IT_GU - IT_P4 - CV_XL) / 2)
#endif
#ifndef CV_SPLIT_D
#define CV_SPLIT_D (IT_GU + IT_D / 2)
#endif
__global__ void __launch_bounds__(512, 2) hybrid_fwd(Args A) {
    extern __shared__ __attribute__((aligned(16))) unsigned char lds_raw[];
    LAS unsigned char* lds = (LAS unsigned char*)lds_raw;
    const int tid = threadIdx.x, lane = tid & 63, wave = __builtin_amdgcn_readfirstlane(tid >> 6), bx = blockIdx.x, G = gridDim.x;
    for (int u = tid; u < (LDS_BYTES - TAB_OFF) / 4; u += 512) ((LAS unsigned*)(lds + TAB_OFF))[u] = 0u;
    __syncthreads();
    CArgs* kap = (CArgs*)__builtin_amdgcn_kernarg_segment_ptr();
#define KA() (*({ CArgs* p_ = kap; asm volatile("" : "+s"(p_)); p_; }))
    XcdBarrier bar = xcd_barrier_post((unsigned*)(A.ws + WS_CTL) + CW_BAR + A.li * XCD_BAR_WORDS, (volatile LAS unsigned*)(lds + TAB_OFF + 1024));
    const int lo = A.ph_lo, hi = A.ph_hi;
#define IN(k) (lo <= (k) && (k) < hi)
#ifndef PROBE_MASK
#define PROBE_MASK 0
#endif
#define REP(k) for (int rep_ = 0; rep_ < (((PROBE_MASK) >> (k)) & 1) + 1; ++rep_)
#define SEAM(k) do { if (IN(k) && IN((k) + 1)) xcd_barrier(bar); } while (0)

    if (IN(0)) REP(0) { p0_prologue(KA(), lds, tid, lane, wave, bx, G); } SEAM(0);
    if (IN(1)) REP(1) { p1_norm(KA(), lds, lane, wave, bx, G); } SEAM(1);
    if (IN(2)) REP(2) {
        unsigned char* ws = KA().ws;
        pg8::Gemm g{(const pg8::bf16_t*)(ws + WS_HA), (const pg8::bf16_t*)(ws + WS_WIN), MA, NINP, D / 2};
        InProjOrder S; S.init(G, bx);
        EpiInProj E{(bf16*)(ws + WS_Z), (bf16*)(ws + WS_XBC), (bf16*)(ws + WS_V), (float*)(ws + WS_DT), (const float*)(ws + WQ_HASC), (const float*)(ws + WQ_WSC)};
        const int half = (bx >> 3) & 1, rank = (((bx >> 4) << 3) + (bx & 7)) * 8 + wave, nrank = (G >> 1) * 8;
        const int cvend = IT_GU - IT_P4 - CV_XL; const bool light = bx >= 212;
        if (half) { conv_static(KA(), 0, CV_SPLIT, rank, nrank, lds, lane, wave); if (light) conv_static(KA(), cvend, cvend + CV_XL, (bx - 212) * 8 + wave, 352, lds, lane, wave); __syncthreads(); }
        pg8::gemm_phase<EpiInProj, InProjOrder, PG8_ALIGN, PG8_SP2, true>(lds, g, S, E);
        if (!half) { conv_static(KA(), CV_SPLIT, cvend, rank, nrank, lds, lane, wave); if (light) conv_static(KA(), cvend, cvend + CV_XL, (bx - 212) * 8 + wave, 352, lds, lane, wave); }
        __syncthreads();
    } SEAM(2);
    if (IN(3)) REP(3) { p3_confconv(KA(), lds, tid, bx, G); p3_ssdconv(KA(), tid, bx, G); } SEAM(3);
    if (IN(4)) REP(4) { p4_scan(KA(), lds, tid, lane, wave, bx, G); } SEAM(4);
    if (IN(5)) REP(5) { p5_mix(KA(), lane, wave, bx, G); } SEAM(5);
    if (IN(6)) REP(6) {
        CArgs& B = KA(); unsigned char* ws = B.ws;
        pg8::Gemm g{(const pg8::bf16_t*)(ws + WS_MIX), (const pg8::bf16_t*)(ws + WS_WOUT), M, D, 2048};
        pg8::StaticOrder S; S.init(M, D, G, bx);
        EpiOutProj E{B.in[I_X], (const float*)(ws + WS_MOD), (bf16*)(ws + WS_X1), (const float*)(ws + WQ_MSC), (const float*)(ws + WQ_WSC)};
        pg8::gemm_phase<EpiOutProj, pg8::StaticOrder, PG8_ALIGN, PG8_SP2, true>(lds, g, S, E);
    } SEAM(6);
    if (IN(7)) REP(7) { p7_router(KA(), lds, tid, lane, wave, bx, G); } SEAM(7);
    if (IN(8)) REP(8) { p8_route(KA(), lds, tid, lane, wave, bx, G); } SEAM(8);
    if (IN(9) || IN(10)) {
        unsigned char* ws = KA().ws;
        LAS int* cumT = (LAS int*)(lds + TAB_OFF);
        { int t2 = tid; asm volatile("" : "+v"(t2)); if (t2 < 99) cumT[t2] = ((const int*)(ws + WS_ROUTE + RT_CUMT))[t2]; }
        __syncthreads();
    }
    if (IN(9)) REP(9) {
        CArgs& B = KA(); unsigned char* ws = B.ws;
        pg8::Gemm g{(const pg8::bf16_t*)(ws + WS_HS), (const pg8::bf16_t*)(ws + WS_WGU), MPMAX, NE * 4096, D / 2};
        MoeOrder S{(const LAS int*)(lds + TAB_OFF), 16, G, bx};
        EpiGateUp E{B.in[I_BGU], (const float*)(ws + WQ_SSA), (const float*)(ws + WQ_WSC), (const float*)(ws + WS_ROUTE + RT_ASC), ws + WS_ACT};
        const int grp = (bx >> 3) & 7, rank = (((bx >> 6) << 3) + (bx & 7)) * 8 + wave, it_lo = IT_GU + grp * (IT_D / 8);
#pragma unroll 1
        for (int seg = 0; seg < 2; ++seg) {
            S.i0 = seg ? grp : 0; S.i1 = seg ? (1 << 20) : grp;
            pg8::gemm_phase<EpiGateUp, MoeOrder, PG8_ALIGN, PG8_SP2, true, true>(lds, g, S, E);
            if (seg == 0) conv_static(B, it_lo, it_lo + IT_D / 8, rank, 256, lds, lane, wave);
        }
    } SEAM(9);
    if (IN(10)) REP(10) {
        CArgs& B = KA(); unsigned char* ws = B.ws;
        pg8::Gemm g{(const pg8::bf16_t*)(ws + WS_ACT), (const pg8::bf16_t*)(ws + WS_WD), MPMAX, NE * 2048, DFF / 2};
        MoeOrder S{(const LAS int*)(lds + TAB_OFF), 8, G, bx};
        EpiDown E{B.in[I_BD], (const float*)(ws + WS_ROUTE + RT_SW), (const float*)(ws + WS_ROUTE + RT_ASC), (const float*)(ws + WQ_WSC), (bf16*)(ws + WS_YS)};
        pg8::gemm_phase<EpiDown, MoeOrder, PG8_ALIGN, PG8_SP2, true, true>(lds, g, S, E);
    } SEAM(10);
    if (IN(11)) REP(11) { p11_final(KA(), lane, wave, bx, G); }
#undef IN
#undef SEAM
}

extern "C" void kernel_launch(void* const* d_in, const int* in_sizes, int n_in, void* d_out, int out_size, void* d_ws, size_t ws_size, hipStream_t stream) {
    static int grid = 0;
    if (grid == 0) {
        if (n_in != 29 || out_size != M * D || ws_size < WS_END) { fprintf(stderr, "kernel_launch: unexpected problem (n_in %d, out %d, ws %zu)\n", n_in, out_size, ws_size); grid = -1; return; }
        if (hipFuncSetAttribute((const void*)hybrid_fwd, hipFuncAttributeMaxDynamicSharedMemorySize, LDS_BYTES) != hipSuccess) { fprintf(stderr, "kernel_launch: hipFuncSetAttribute failed\n"); grid = -1; return; }
        int per_cu = 0;
        if (hipOccupancyMaxActiveBlocksPerMultiprocessor(&per_cu, (const void*)hybrid_fwd, 512, LDS_BYTES) != hipSuccess || per_cu < 1) fprintf(stderr, "kernel_launch: occupancy query reports %d\n", per_cu);
        (void)hipGetLastError();
        grid = 256;
    }
    if (grid < 0) return;
    (void)in_sizes;
    if (hipMemsetAsync((char*)d_ws + WS_CTL, 0, CTL_ZERO_BYTES, stream) != hipSuccess) { fprintf(stderr, "kernel_launch: memset failed\n"); return; }
    Args a{};
    for (int i = 0; i < 29; ++i) a.in[i] = (const float*)d_in[i];
    a.out = (float*)d_out; a.ws = (unsigned char*)d_ws; a.pad = 0;
#if MK_LAUNCHES == 1
    a.ph_lo = 0; a.ph_hi = NPHASE; a.li = 0;
    hipLaunchKernelGGL(hybrid_fwd, dim3(grid), dim3(512), LDS_BYTES, stream, a);
#else
    for (int li = 0; li < NPHASE; ++li) { a.ph_lo = li; a.ph_hi = li + 1; a.li = li; hipLaunchKernelGGL(hybrid_fwd, dim3(grid), dim3(512), LDS_BYTES, stream, a); }
#endif
    const hipError_t le = hipPeekAtLastError();
    if (le != hipSuccess) fprintf(stderr, "kernel_launch: launch failed: %s\n", hipGetErrorName(le));
}
```
